# Optimizing an MI355X kernel written in HIP

```python
import math
import jax, jax.numpy as jnp
from jax import lax
import numpy as np

D_MODEL = 1024
BATCH = 16
SEQ = 2048
DEPTH = 1

N_META = 16
D_MIX = D_MODEL
N_HEADS = 8
QK_NOPE = 64
QK_ROPE = 32
QK_HEAD = QK_NOPE + QK_ROPE
V_HEAD = 64
D_ATTN = N_HEADS * V_HEAD
Q_LORA = 384
KV_LORA = 256
D_RNN = D_MIX - D_ATTN
RNN_BLOCKS = 8
RNN_BW = D_RNN // RNN_BLOCKS
CONV_W = 4
CONV_PAD = (2, 1)
LRU_C = 8.0
ROPE_THETA = 10000.0
Q_BLOCK = 128
OFF_CQ = Q_LORA
OFF_CKV = OFF_CQ + KV_LORA
OFF_KR = OFF_CKV + QK_ROPE
OFF_XR = OFF_KR + D_RNN
IN_COLS = OFF_XR + D_RNN
D_FF = int(math.ceil(8 * D_MODEL / 3 / 256) * 256)
EPS = 1e-6

kernel_name = "hymba_mla_rglru_hybrid_encoder"


def rms_norm(x, g):
    xf = x.astype(jnp.float32)
    y = xf * lax.rsqrt(jnp.mean(xf * xf, axis=-1, keepdims=True) + EPS)
    return (y * g.astype(jnp.float32)).astype(x.dtype)


def rope(x, pos):
    half = x.shape[-1] // 2
    freqs = 1.0 / (ROPE_THETA ** (jnp.arange(half, dtype=jnp.float32) / half))
    ang = pos[:, None] * freqs[None, :]
    cos = jnp.cos(ang)[None, :, None, :]
    sin = jnp.sin(ang)[None, :, None, :]
    xf = x.astype(jnp.float32)
    x1, x2 = xf[..., :half], xf[..., half:]
    out = jnp.concatenate([x1 * cos - x2 * sin, x1 * sin + x2 * cos], axis=-1)
    return out.astype(x.dtype)


def attend_block(q_blk, k, v):
    s = jnp.einsum('bhqd,bhkd->bhqk', q_blk, k).astype(jnp.float32) * (QK_HEAD ** -0.5)
    p = jax.nn.softmax(s, axis=-1)
    return jnp.einsum('bhqk,bhkd->bhqd', p.astype(v.dtype), v)


def mla_group(c_q, c_kv, k_r, q_a_g, w_uq, kv_a_g, w_ukv, q_g, k_g, pos):
    B, T, _ = c_q.shape
    q = (rms_norm(c_q, q_a_g) @ w_uq).reshape(B, T, N_HEADS, QK_HEAD)
    kv = (rms_norm(c_kv, kv_a_g) @ w_ukv).reshape(B, T, N_HEADS, QK_NOPE + V_HEAD)
    k_nope, v = kv[..., :QK_NOPE], kv[..., QK_NOPE:]
    k = jnp.concatenate([k_nope, jnp.broadcast_to(k_r[:, :, None, :], (B, T, N_HEADS, QK_ROPE))], axis=-1)
    q = rms_norm(q, q_g)
    k = rms_norm(k, k_g)
    q = jnp.concatenate([q[..., :QK_NOPE], rope(q[..., QK_NOPE:], pos)], axis=-1)
    k = jnp.concatenate([k[..., :QK_NOPE], rope(k[..., QK_NOPE:], pos)], axis=-1)
    q = q.transpose(0, 2, 1, 3)
    k = k.transpose(0, 2, 1, 3)
    v = v.transpose(0, 2, 1, 3)
    o_meta = attend_block(q[:, :, :N_META], k, v)
    q_real = q[:, :, N_META:]
    n_blk = q_real.shape[2] // Q_BLOCK
    q_blocks = q_real.reshape(B, N_HEADS, n_blk, Q_BLOCK, QK_HEAD).transpose(2, 0, 1, 3, 4)
    o_blocks = lax.map(lambda qb: attend_block(qb, k, v), q_blocks)
    o_real = o_blocks.transpose(1, 2, 0, 3, 4).reshape(B, N_HEADS, n_blk * Q_BLOCK, V_HEAD)
    o = jnp.concatenate([o_meta, o_real], axis=2)
    return o.transpose(0, 2, 1, 3).reshape(B, T, D_ATTN)


def _linear_combine(c1, c2):
    a1, b1 = c1
    a2, b2 = c2
    return a1 * a2, a2 * b1 + b2


def rg_lru(xc, wa, ba, wi, bi, lam, reverse):
    B, T, _ = xc.shape
    xg = xc.reshape(B, T, RNN_BLOCKS, RNN_BW)
    r = jax.nn.sigmoid((jnp.einsum('btgi,gij->btgj', xg, wa).reshape(B, T, D_RNN) + ba).astype(jnp.float32))
    i = jax.nn.sigmoid((jnp.einsum('btgi,gij->btgj', xg, wi).reshape(B, T, D_RNN) + bi).astype(jnp.float32))
    log_a = -LRU_C * r * jax.nn.softplus(-lam.astype(jnp.float32))
    a = jnp.exp(log_a)
    b = jnp.sqrt(jnp.maximum(-jnp.expm1(2.0 * log_a), 0.0)) * (i * xc.astype(jnp.float32))
    _, h = lax.associative_scan(_linear_combine, (a, b), axis=1, reverse=reverse)
    return h.astype(xc.dtype)


def rglru_group(x_r, x_gate, conv_w, conv_b, wa, ba, wi, bi, lam):
    xc = lax.conv_general_dilated(
        x_r, conv_w[:, None, :], window_strides=(1,), padding=[CONV_PAD],
        dimension_numbers=('NWC', 'WIO', 'NWC'), feature_group_count=D_RNN) + conv_b
    y = rg_lru(xc, wa[0], ba[0], wi[0], bi[0], lam[0], reverse=False) \
        + rg_lru(xc, wa[1], ba[1], wi[1], bi[1], lam[1], reverse=True)
    return y * jax.nn.gelu(x_gate)


def setup_inputs(seed: int = 0) -> dict:
    key = jax.random.key(seed)
    ks = iter(jax.random.split(key, 40))
    L = DEPTH
    f32 = jnp.float32

    def nrm(shape, fan_in):
        return jax.random.normal(next(ks), shape, f32) * (fan_in ** -0.5)

    def gain(shape):
        return 1.0 + 0.02 * jax.random.normal(next(ks), shape, f32)

    def bias(shape):
        return 0.01 * jax.random.normal(next(ks), shape, f32)

    x = jax.random.normal(next(ks), (BATCH, SEQ, D_MODEL), f32)
    meta_tokens = jax.random.normal(next(ks), (N_META, D_MODEL), f32)
    u = jax.random.uniform(next(ks), (L, 2, D_RNN), f32, 0.9, 0.999)
    s = u ** (1.0 / LRU_C)
    lru_lambda = jnp.log(s) - jnp.log1p(-s)
    return {
        "x": x,
        "meta_tokens": meta_tokens,
        "ln1_g": gain((L, D_MODEL)),
        "w_in": nrm((L, D_MODEL, IN_COLS), D_MODEL),
        "q_a_norm_g": gain((L, Q_LORA)),
        "w_uq": nrm((L, Q_LORA, N_HEADS * QK_HEAD), Q_LORA),
        "kv_a_norm_g": gain((L, KV_LORA)),
        "w_ukv": nrm((L, KV_LORA, N_HEADS * (QK_NOPE + V_HEAD)), KV_LORA),
        "q_norm_g": gain((L, QK_HEAD)),
        "k_norm_g": gain((L, QK_HEAD)),
        "conv_w": nrm((L, CONV_W, D_RNN), CONV_W),
        "conv_b": bias((L, D_RNN)),
        "lru_wa": nrm((L, 2, RNN_BLOCKS, RNN_BW, RNN_BW), RNN_BW),
        "lru_ba": bias((L, 2, D_RNN)),
        "lru_wi": nrm((L, 2, RNN_BLOCKS, RNN_BW, RNN_BW), RNN_BW),
        "lru_bi": bias((L, 2, D_RNN)),
        "lru_lambda": lru_lambda,
        "attn_out_g": gain((L, D_ATTN)),
        "rnn_out_g": gain((L, D_RNN)),
        "w_out": nrm((L, D_MIX, D_MODEL), D_MIX),
        "ln2_g": gain((L, D_MODEL)),
        "w_gate": nrm((L, D_MODEL, D_FF), D_MODEL),
        "w_up": nrm((L, D_MODEL, D_FF), D_MODEL),
        "w_down": nrm((L, D_FF, D_MODEL), D_FF),
    }


def reference(x, meta_tokens, ln1_g, w_in, q_a_norm_g, w_uq, kv_a_norm_g, w_ukv,
              q_norm_g, k_norm_g, conv_w, conv_b, lru_wa, lru_ba, lru_wi, lru_bi,
              lru_lambda, attn_out_g, rnn_out_g, w_out, ln2_g, w_gate, w_up, w_down):
    B = x.shape[0]
    meta = jnp.broadcast_to(meta_tokens[None].astype(x.dtype), (B, N_META, x.shape[-1]))
    h = jnp.concatenate([meta, x], axis=1)
    T = h.shape[1]
    pos = jnp.arange(T, dtype=jnp.float32)
    for l in range(DEPTH):
        hn = rms_norm(h, ln1_g[l])
        p = hn @ w_in[l]
        c_q = p[..., :OFF_CQ]
        c_kv = p[..., OFF_CQ:OFF_CKV]
        k_r = p[..., OFF_CKV:OFF_KR]
        x_r = p[..., OFF_KR:OFF_XR]
        x_gate = p[..., OFF_XR:]
        o_attn = mla_group(c_q, c_kv, k_r, q_a_norm_g[l], w_uq[l], kv_a_norm_g[l],
                           w_ukv[l], q_norm_g[l], k_norm_g[l], pos)
        o_rnn = rglru_group(x_r, x_gate, conv_w[l], conv_b[l], lru_wa[l], lru_ba[l],
                            lru_wi[l], lru_bi[l], lru_lambda[l])
        mix = jnp.concatenate([rms_norm(o_attn, attn_out_g[l]), rms_norm(o_rnn, rnn_out_g[l])], axis=-1)
        h = h + mix @ w_out[l]
        hn = rms_norm(h, ln2_g[l])
        h = h + (jax.nn.silu(hn @ w_gate[l]) * (hn @ w_up[l])) @ w_down[l]
    return h[:, N_META:]
```

```cpp
#include <hip/hip_runtime.h>
#include <hip/hip_cooperative_groups.h>
#include <cstdio>
#include <cstdint>
namespace cg = cooperative_groups;

#define LAS __attribute__((address_space(3)))
typedef unsigned short bf16_t;
typedef short bf16x8 __attribute__((ext_vector_type(8)));
typedef float f32x4 __attribute__((ext_vector_type(4)));
typedef float f32x16 __attribute__((ext_vector_type(16)));
typedef unsigned u32x4 __attribute__((ext_vector_type(4)));
typedef unsigned u32x2 __attribute__((ext_vector_type(2)));

constexpr int BATCH = 16, SEQ = 2048, NMETA = 16, TT = SEQ + NMETA, DM = 1024;
constexpr int MT = BATCH * TT;
constexpr int MR = BATCH * SEQ;
constexpr int INC = 1696, INP = 1792;
constexpr int C_CKV = 384, C_KR = 640, C_XR = 672, C_GATE = 1184;
constexpr int NH = 8, QKH = 96, TKP = 2112, NKT = TKP / 64;
constexpr int DFF = 2816, NCH = 17;
constexpr float EPS = 1e-6f;
constexpr float QSCALE = 0.10206207261596577f * 1.4426950408889634f;

constexpr size_t MiB = 1u << 20;
constexpr size_t WS_SS = 0;
constexpr size_t WS_BAR = 1 * MiB;
constexpr int BAR_ZERO_BYTES = 65536;
constexpr size_t WS_WLRU = 4 * MiB;
constexpr size_t WS_WIN = 5 * MiB, WS_WUQ = 9 * MiB, WS_WUKV = 10 * MiB, WS_WOUT = 11 * MiB, WS_WGU = 13 * MiB, WS_WDN = 25 * MiB;
constexpr size_t WS_HB = 32 * MiB;
constexpr size_t WS_P = 100 * MiB;
constexpr size_t WS_Q = 213 * MiB;
constexpr size_t WS_K = 261 * MiB;
constexpr size_t WS_VT = 311 * MiB;
constexpr size_t WS_MIX = 344 * MiB;
constexpr size_t WS_H = 408 * MiB;
constexpr size_t WS_END = 473 * MiB;
constexpr int LDS_BYTES = 147456;

struct Params { const float* in[24]; float* out; unsigned char* ws; int ph_lo, ph_hi, li, pad; };

__device__ __forceinline__ unsigned cvt_pk(float lo, float hi) { unsigned r; asm("v_cvt_pk_bf16_f32 %0, %1, %2" : "=v"(r) : "v"(lo), "v"(hi)); return r; }
__device__ __forceinline__ float bf2f(unsigned short b) { return __uint_as_float(((unsigned)b) << 16); }
__device__ __forceinline__ float bflo(unsigned w) { return __uint_as_float(w << 16); }
__device__ __forceinline__ float bfhi(unsigned w) { return __uint_as_float(w & 0xffff0000u); }
__device__ __forceinline__ float wave_sum(float v) {
#pragma unroll
    for (int o = 1; o < 64; o <<= 1) v += __shfl_xor(v, o);
    return v;
}
__device__ __forceinline__ void fadd_atomic(float* p, float v) { __hip_atomic_fetch_add(p, v, __ATOMIC_RELAXED, __HIP_MEMORY_SCOPE_AGENT); }
__device__ __forceinline__ float frsq(float x) { return __builtin_amdgcn_rsqf(x); }
__device__ __forceinline__ float sigmoidf_(float x) { return 1.0f / (1.0f + __expf(-x)); }
__device__ __forceinline__ void sincos_rr(float x, float& s, float& c) {
    const float k = rintf(x * 0.15915494309189535f);
    float r = fmaf(-k, 6.2831854820251465f, x);
    r = fmaf(-k, -1.7484555314695172e-7f, r);
    const float rev = r * 0.15915494309189535f;
    s = __builtin_amdgcn_sinf(rev); c = __builtin_amdgcn_cosf(rev);
}

namespace pg8 {
#define PG8_LAS __attribute__((address_space(3)))
constexpr int BM = 256, BK = 64, HALF = 128, HTB = HALF * BK * 2, STAGE_BYTES = 8 * HTB, NXCD = 8, WGM = 8;
__host__ __device__ __forceinline__ int lds_byte(int r, int c) { const int st = (r >> 4) * 2 + (c >> 5), rr = r & 15, cc = c & 31, ob = rr * 64 + cc * 2; return st * 1024 + (ob ^ (((ob >> 9) & 1) << 5)); }
__host__ __device__ __forceinline__ void stage_rc(int b, int& R, int& C) { const int st = b / 1024, sb = b % 1024, swz = sb ^ (((sb >> 9) & 1) << 5); R = (st >> 1) * 16 + swz / 64; C = (st & 1) * 32 + (swz % 64) / 2; }
__host__ __device__ __forceinline__ int perm32(int rho) { const int n = rho >> 4, i = rho & 15; return 8 * (i >> 2) + 4 * n + (i & 3); }
struct Unit { int pm, pn; };
struct Gemm { const bf16_t* A; const bf16_t* Bt; int M, N, K, lda, ldb; };
struct StaticOrder {
    int nM, nN, nwg, G, c;
    __device__ void init(int M, int N, int G_, int c_) { nM = M / BM; nN = N / BM; nwg = nM * nN; G = G_; c = c_; }
    __device__ bool next(int i, Unit& u) const {
        const long L = (long)i * G + c; if (L >= nwg) return false;
        int wgid = (int)L; { const int q = nwg / NXCD, r = nwg % NXCD, xcd = wgid % NXCD, off = wgid / NXCD; wgid = (xcd < r ? xcd * (q + 1) : r * (q + 1) + (xcd - r) * q) + off; }
        const int nig = WGM * nN, gid = wgid / nig, fm = gid * WGM, gsz = (nM - fm) < WGM ? (nM - fm) : WGM;
        u.pm = fm + ((wgid % nig) % gsz); u.pn = (wgid % nig) / gsz; return true;
    }
};
template <class Epi, class Sched, bool ALIGN_EPI>
__device__ __forceinline__ void gemm_phase(PG8_LAS unsigned char* lds, const Gemm g, const Sched& S, const Epi& E) {
    const int tid = threadIdx.x, wid = __builtin_amdgcn_readfirstlane(tid >> 6), lane = tid & 63, wr = wid >> 2, wc = wid & 3, fr = lane & 15, fq = lane >> 4;
    const int K = g.K, nt = K / BK;
    unsigned voffA[2], voffB[2];
#pragma unroll
    for (int i = 0; i < 2; ++i) { int R, C; stage_rc(tid * 16 + i * 8192, R, C); const int Rb = Epi::PERM ? ((R & ~31) + perm32(R & 31)) : R;
        voffA[i] = (unsigned)(R * g.lda + C) * 2u; voffB[i] = (unsigned)(Rb * g.ldb + C) * 2u; }
    const size_t kstep = (size_t)(BK * 2);
    const size_t hsA = (size_t)HALF * g.lda * 2, hsB = (size_t)HALF * g.ldb * 2, tsA = 2 * hsA, tsB = 2 * hsB;
    const unsigned ldsw = (unsigned)wid * 1024u;
    const int aoff = lds_byte(wr * 64 + fr, fq * 8), boff = lds_byte(wc * 32 + fr, fq * 8);
#define PG8_SA(b, h) (((b) * 2 + (h)) * HTB)
#define PG8_SB(b, h) ((4 + (b) * 2 + (h)) * HTB)
#define PG8_STAGE(bufoff, gbase, voff) do { _Pragma("unroll") for (int _i = 0; _i < 2; ++_i) \
        __builtin_amdgcn_global_load_lds((const unsigned*)((const char*)(gbase) + (voff)[_i]), (PG8_LAS unsigned*)(lds + (bufoff) + ldsw + _i * 8192), 16, 0, 0); } while (0)
#define PG8_LDA(dst, b, h) do { _Pragma("unroll") for (int m = 0; m < 4; ++m) _Pragma("unroll") for (int k = 0; k < 2; ++k) dst[m][k] = *(const PG8_LAS bf16x8*)(lds + PG8_SA(b, h) + aoff + m * 2048 + k * 1024); } while (0)
#define PG8_LDB(dst, b, h) do { _Pragma("unroll") for (int n = 0; n < 2; ++n) _Pragma("unroll") for (int k = 0; k < 2; ++k) dst[n][k] = *(const PG8_LAS bf16x8*)(lds + PG8_SB(b, h) + boff + n * 2048 + k * 1024); } while (0)
#define PG8_MMA(ai, bj, At, Bt) do { __builtin_amdgcn_s_setprio(1); _Pragma("unroll") for (int m = 0; m < 4; ++m) _Pragma("unroll") for (int n = 0; n < 2; ++n) _Pragma("unroll") for (int k = 0; k < 2; ++k) \
        acc[ai][bj][m][n] = __builtin_amdgcn_mfma_f32_16x16x32_bf16(Bt[n][k], At[m][k], acc[ai][bj][m][n], 0, 0, 0); __builtin_amdgcn_s_setprio(0); } while (0)
#define PG8_WAIT_V(n) asm volatile("s_waitcnt vmcnt(" #n ")" ::: "memory")
#define PG8_WAIT_L(n) asm volatile("s_waitcnt lgkmcnt(" #n ")" ::: "memory")
#define PG8_BAR __builtin_amdgcn_s_barrier()
#define PG8_SCHED __builtin_amdgcn_sched_barrier(0)
    Unit cur, nxt; int ui = 0;
    if (!S.next(0, cur)) return;
    f32x4 acc[2][2][4][2];
#pragma unroll
    for (int a = 0; a < 2; ++a)
#pragma unroll
        for (int b = 0; b < 2; ++b)
#pragma unroll
            for (int m = 0; m < 4; ++m)
#pragma unroll
                for (int n = 0; n < 2; ++n) acc[a][b][m][n] = (f32x4){0.f, 0.f, 0.f, 0.f};
    bf16x8 At[4][2], B0[2][2], B1[2][2];
    const char* cA = (const char*)g.A + (size_t)cur.pm * tsA; const char* cB = (const char*)g.Bt + (size_t)cur.pn * tsB;
    PG8_STAGE(PG8_SB(0, 0), cB, voffB); PG8_STAGE(PG8_SB(0, 1), cB + hsB, voffB); PG8_STAGE(PG8_SA(0, 0), cA, voffA); PG8_STAGE(PG8_SA(0, 1), cA + hsA, voffA);
    if (wr == 1) PG8_BAR;
    PG8_WAIT_V(2); PG8_BAR;
    PG8_STAGE(PG8_SB(1, 0), cB + kstep, voffB); PG8_STAGE(PG8_SA(1, 0), cA + kstep, voffA); PG8_STAGE(PG8_SB(1, 1), cB + hsB + kstep, voffB);
    PG8_WAIT_V(6); PG8_BAR;
    for (;;) {
        const bool has_next = S.next(ui + 1, nxt);
        const char* nA = has_next ? (const char*)g.A + (size_t)nxt.pm * tsA : cA; const char* nB = has_next ? (const char*)g.Bt + (size_t)nxt.pn * tsB : cB;
        for (int t = 0; t < nt; t += 2) {
            const bool last = (t == nt - 2);
            const char* a1 = cA + (size_t)(t + 1) * kstep;
            const char* a2 = last ? nA : cA + (size_t)(t + 2) * kstep; const char* b2 = last ? nB : cB + (size_t)(t + 2) * kstep;
            const char* a3 = a2 + kstep; const char* b3 = b2 + kstep;
            if constexpr (Epi::MID_T >= 0) { if (t == Epi::MID_T) E.mid(acc, cur, wr, fr); }
            PG8_LDB(B0, 0, 0); PG8_LDB(B1, 0, 1); PG8_SCHED; PG8_LDA(At, 0, 0); PG8_STAGE(PG8_SA(1, 1), a1 + hsA, voffA);
            PG8_WAIT_V(8); PG8_WAIT_L(0); PG8_BAR; PG8_MMA(0, 0, At, B0); PG8_MMA(0, 1, At, B1); PG8_BAR; PG8_SCHED;
            PG8_LDA(At, 0, 1); PG8_STAGE(PG8_SB(0, 0), b2, voffB); PG8_STAGE(PG8_SB(0, 1), b2 + hsB, voffB); PG8_STAGE(PG8_SA(0, 0), a2, voffA);
            PG8_WAIT_V(8); PG8_WAIT_L(0); PG8_BAR; PG8_MMA(1, 0, At, B0); PG8_MMA(1, 1, At, B1); PG8_BAR; PG8_SCHED;
            PG8_LDB(B0, 1, 0); PG8_LDB(B1, 1, 1); PG8_SCHED; PG8_LDA(At, 1, 0); PG8_STAGE(PG8_SA(0, 1), a2 + hsA, voffA);
            PG8_WAIT_V(8); PG8_WAIT_L(0); PG8_BAR; PG8_MMA(0, 0, At, B0); PG8_MMA(0, 1, At, B1); PG8_BAR; PG8_SCHED;
            PG8_LDA(At, 1, 1); PG8_STAGE(PG8_SB(1, 0), b3, voffB); PG8_STAGE(PG8_SB(1, 1), b3 + hsB, voffB); PG8_STAGE(PG8_SA(1, 0), a3, voffA);
            PG8_WAIT_V(8); PG8_WAIT_L(0); PG8_BAR; PG8_MMA(1, 0, At, B0); PG8_MMA(1, 1, At, B1); PG8_BAR; PG8_SCHED;
        }
        if constexpr (ALIGN_EPI) { if (wr == 0) PG8_BAR; }
        E(acc, cur, wr, wc, fr, fq);
        if (!has_next) break;
#pragma unroll
        for (int a = 0; a < 2; ++a)
#pragma unroll
            for (int b = 0; b < 2; ++b)
#pragma unroll
                for (int m = 0; m < 4; ++m)
#pragma unroll
                    for (int n = 0; n < 2; ++n) acc[a][b][m][n] = (f32x4){0.f, 0.f, 0.f, 0.f};
        cur = nxt; cA = nA; cB = nB; ++ui;
        if constexpr (ALIGN_EPI) { if (wr == 1) PG8_BAR; }
    }
    PG8_WAIT_V(0);
    if constexpr (!ALIGN_EPI) { if (wr == 0) PG8_BAR; }
    PG8_BAR;
#undef PG8_SA
#undef PG8_SB
#undef PG8_STAGE
#undef PG8_LDA
#undef PG8_LDB
#undef PG8_MMA
#undef PG8_WAIT_V
#undef PG8_WAIT_L
#undef PG8_BAR
#undef PG8_SCHED
}

struct EpiInProj {
    static constexpr bool PERM = true; static constexpr int MID_T = 14;
    bf16_t* P; const float* rs1; float* ss_cq; float* ss_ckv; mutable float pre[8];
    __device__ __forceinline__ void mid(f32x4 (&)[2][2][4][2], const Unit& u, int wr, int fr) const {
        int row0 = u.pm * BM + wr * 64 + fr; asm volatile("" : "+v"(row0));
#pragma unroll
        for (int ai = 0; ai < 2; ++ai)
#pragma unroll
            for (int m = 0; m < 4; ++m) pre[ai * 4 + m] = rs1[row0 + ai * HALF + m * 16];
    }
    __device__ __forceinline__ void operator()(const f32x4 (&acc)[2][2][4][2], const Unit& u, int wr, int wc, int fr, int fq) const {
        int row0 = u.pm * BM + wr * 64 + fr; asm volatile("" : "+v"(row0));
#pragma unroll
        for (int ai = 0; ai < 2; ++ai)
#pragma unroll
            for (int m = 0; m < 4; ++m) { const int row = row0 + ai * HALF + m * 16; const float s = pre[ai * 4 + m];
#pragma unroll
                for (int bj = 0; bj < 2; ++bj) { const int hc = u.pn * 2 + bj; const int col = u.pn * BM + bj * HALF + wc * 32 + 8 * fq;
                    const f32x4 v0 = acc[ai][bj][m][0] * s, v1 = acc[ai][bj][m][1] * s;
                    u32x4 w; w.x = cvt_pk(v0[0], v0[1]); w.y = cvt_pk(v0[2], v0[3]); w.z = cvt_pk(v1[0], v1[1]); w.w = cvt_pk(v1[2], v1[3]);
                    *(u32x4*)(P + (size_t)row * INP + col) = w;
                    if (hc < 5) { float q = (v0[0] * v0[0] + v0[1] * v0[1]) + (v0[2] * v0[2] + v0[3] * v0[3]) + (v1[0] * v1[0] + v1[1] * v1[1]) + (v1[2] * v1[2] + v1[3] * v1[3]);
                        q += __shfl_xor(q, 16); q += __shfl_xor(q, 32);
                        if (fq == 0) fadd_atomic((hc < 3 ? ss_cq : ss_ckv) + row, q); } } }
    }
};
struct EpiOut {
    static constexpr bool PERM = true; static constexpr int MID_T = 8;
    const float* x; bf16_t* LO; bf16_t* H1B; const float* ss_a; const float* ss_b; float* ss2; mutable float pre[8];
    __device__ __forceinline__ void mid(f32x4 (&acc)[2][2][4][2], const Unit& u, int wr, int fr) const {
        int row0 = u.pm * BM + wr * 64 + fr; asm volatile("" : "+v"(row0));
#pragma unroll
        for (int ai = 0; ai < 2; ++ai)
#pragma unroll
            for (int m = 0; m < 4; ++m) { const int row = row0 + ai * HALF + m * 16;
                const float ra = frsq(ss_a[row] * (1.0f / 512.0f) + EPS), rb = frsq(ss_b[row] * (1.0f / 512.0f) + EPS); const float ratio = ra * __builtin_amdgcn_rcpf(rb); pre[ai * 4 + m] = rb;
#pragma unroll
                for (int bj = 0; bj < 2; ++bj)
#pragma unroll
                    for (int n = 0; n < 2; ++n) acc[ai][bj][m][n] *= ratio; }
    }
    __device__ __forceinline__ void operator()(const f32x4 (&acc)[2][2][4][2], const Unit& u, int wr, int wc, int fr, int fq) const {
        int row0 = u.pm * BM + wr * 64 + fr; asm volatile("" : "+v"(row0));
#pragma unroll
        for (int ai = 0; ai < 2; ++ai)
#pragma unroll
            for (int m = 0; m < 4; ++m) { const int row = row0 + ai * HALF + m * 16; const float rb = pre[ai * 4 + m]; float q = 0.f;
#pragma unroll
                for (int bj = 0; bj < 2; ++bj) { const size_t off = (size_t)row * DM + u.pn * BM + bj * HALF + wc * 32 + 8 * fq;
                    const f32x4 x0 = *(const f32x4*)(x + off), x1 = *(const f32x4*)(x + off + 4);
                    const f32x4 h0 = x0 + acc[ai][bj][m][0] * rb, h1 = x1 + acc[ai][bj][m][1] * rb;
                    u32x4 w; w.x = cvt_pk(h0[0], h0[1]); w.y = cvt_pk(h0[2], h0[3]); w.z = cvt_pk(h1[0], h1[1]); w.w = cvt_pk(h1[2], h1[3]); *(u32x4*)(H1B + off) = w;
                    u32x4 l; l.x = cvt_pk(h0[0] - bflo(w.x), h0[1] - bfhi(w.x)); l.y = cvt_pk(h0[2] - bflo(w.y), h0[3] - bfhi(w.y)); l.z = cvt_pk(h1[0] - bflo(w.z), h1[1] - bfhi(w.z)); l.w = cvt_pk(h1[2] - bflo(w.w), h1[3] - bfhi(w.w));
                    *(u32x4*)(LO + off) = l;
                    q += (h0[0] * h0[0] + h0[1] * h0[1]) + (h0[2] * h0[2] + h0[3] * h0[3]) + (h1[0] * h1[0] + h1[1] * h1[1]) + (h1[2] * h1[2] + h1[3] * h1[3]); }
                q += __shfl_xor(q, 16); q += __shfl_xor(q, 32);
                if (fq == 0) fadd_atomic(ss2 + row, q);
                if (m & 1) asm volatile("" ::: "memory"); }
    }
};
struct EpiUp {
    static constexpr bool PERM = true; static constexpr int MID_T = 14;
    bf16_t* ACT; const float* ss2; mutable float pre[8];
    __device__ __forceinline__ void mid(f32x4 (&)[2][2][4][2], const Unit& u, int wr, int fr) const {
        int row0 = u.pm * BM + wr * 64 + fr; asm volatile("" : "+v"(row0));
#pragma unroll
        for (int ai = 0; ai < 2; ++ai)
#pragma unroll
            for (int m = 0; m < 4; ++m) pre[ai * 4 + m] = ss2[row0 + ai * HALF + m * 16];
    }
    __device__ __forceinline__ void operator()(const f32x4 (&acc)[2][2][4][2], const Unit& u, int wr, int wc, int fr, int fq) const {
        int row0 = u.pm * BM + wr * 64 + fr; asm volatile("" : "+v"(row0)); const int col = u.pn * HALF + wc * 32 + 8 * fq;
#pragma unroll
        for (int ai = 0; ai < 2; ++ai)
#pragma unroll
            for (int m = 0; m < 4; ++m) { const int row = row0 + ai * HALF + m * 16; const float s = frsq(pre[ai * 4 + m] * (1.0f / 1024.0f) + EPS);
                const float c = -1.4426950408889634f * s, s2 = s * s;
                f32x4 r[2];
#pragma unroll
                for (int n = 0; n < 2; ++n) { const f32x4 g = acc[ai][0][m][n], uu = acc[ai][1][m][n];
                    f32x4 e = g * c;
#pragma unroll
                    for (int i = 0; i < 4; ++i) e[i] = __builtin_amdgcn_exp2f(e[i]);
                    f32x4 d = e + 1.0f;
#pragma unroll
                    for (int i = 0; i < 4; ++i) d[i] = __builtin_amdgcn_rcpf(d[i]);
                    r[n] = (g * uu) * (d * s2); }
                u32x4 w; w.x = cvt_pk(r[0][0], r[0][1]); w.y = cvt_pk(r[0][2], r[0][3]); w.z = cvt_pk(r[1][0], r[1][1]); w.w = cvt_pk(r[1][2], r[1][3]);
                *(u32x4*)(ACT + (size_t)row * DFF + col) = w; }
    }
};
struct EpiDown {
    static constexpr bool PERM = true; static constexpr int MID_T = -1;
    float* out; const bf16_t* H1B; const bf16_t* LO;
    __device__ __forceinline__ void mid(f32x4 (&)[2][2][4][2], const Unit&, int, int) const {}
    __device__ __forceinline__ void operator()(const f32x4 (&acc)[2][2][4][2], const Unit& u, int wr, int wc, int fr, int fq) const {
        int row0 = u.pm * BM + wr * 64 + fr; asm volatile("" : "+v"(row0));
#pragma unroll
        for (int ai = 0; ai < 2; ++ai)
#pragma unroll
            for (int m = 0; m < 4; ++m) { const int row = row0 + ai * HALF + m * 16;
#pragma unroll
                for (int bj = 0; bj < 2; ++bj) { const size_t off = (size_t)row * DM + u.pn * BM + bj * HALF + wc * 32 + 8 * fq;
                    const u32x4 hw = *(const u32x4*)(H1B + off), lw = *(const u32x4*)(LO + off);
                    f32x4 o0, o1;
                    o0[0] = (bflo(hw.x) + bflo(lw.x)) + acc[ai][bj][m][0][0]; o0[1] = (bfhi(hw.x) + bfhi(lw.x)) + acc[ai][bj][m][0][1];
                    o0[2] = (bflo(hw.y) + bflo(lw.y)) + acc[ai][bj][m][0][2]; o0[3] = (bfhi(hw.y) + bfhi(lw.y)) + acc[ai][bj][m][0][3];
                    o1[0] = (bflo(hw.z) + bflo(lw.z)) + acc[ai][bj][m][1][0]; o1[1] = (bfhi(hw.z) + bfhi(lw.z)) + acc[ai][bj][m][1][1];
                    o1[2] = (bflo(hw.w) + bflo(lw.w)) + acc[ai][bj][m][1][2]; o1[3] = (bfhi(hw.w) + bfhi(lw.w)) + acc[ai][bj][m][1][3];
                    *(f32x4*)(out + off) = o0; *(f32x4*)(out + off + 4) = o1; } }
    }
};
}

__device__ __forceinline__ void transpose_item(const float* W, int N, const float* gain, bf16_t* WT, int ldt, int dst_row0, int k0, int n0, LAS float* scr, int lane) {
    { const int kq = lane >> 3, nq = lane & 7;
      f32x4 v[8]; float gv[8];
#pragma unroll
      for (int i = 0; i < 8; ++i) { const int kk = 8 * i + kq; gv[i] = gain ? gain[k0 + kk] : 1.0f; v[i] = *(const f32x4*)(W + (size_t)(k0 + kk) * N + n0 + 4 * nq); }
#pragma unroll
      for (int i = 0; i < 8; ++i) { const int kk = 8 * i + kq; LAS float* d = scr + kk * 33 + 4 * nq; d[0] = v[i][0] * gv[i]; d[1] = v[i][1] * gv[i]; d[2] = v[i][2] * gv[i]; d[3] = v[i][3] * gv[i]; } }
    asm volatile("s_waitcnt lgkmcnt(0)" ::: "memory");
    const int c = lane & 7;
#pragma unroll
    for (int j = 0; j < 4; ++j) { const int n = (lane >> 3) + 8 * j; const LAS float* s = scr + (8 * c) * 33 + n;
        u32x4 o; o.x = cvt_pk(s[0 * 33], s[1 * 33]); o.y = cvt_pk(s[2 * 33], s[3 * 33]); o.z = cvt_pk(s[4 * 33], s[5 * 33]); o.w = cvt_pk(s[6 * 33], s[7 * 33]);
        *(u32x4*)(WT + (size_t)(dst_row0 + n) * ldt + k0 + 8 * c) = o; }
    asm volatile("s_waitcnt lgkmcnt(0)" ::: "memory");
}
constexpr int I_WIN = 16 * 53, I_UQ = 6 * 24, I_UKV = 4 * 32, I_OUT = 16 * 32, I_G = 16 * 88, I_DN = 44 * 32;
constexpr int NIT = I_WIN + I_UQ + I_UKV + I_OUT + 2 * I_G + I_DN;
__device__ __forceinline__ void prep_transposes(const Params& p, LAS unsigned char* lds, int lo, int hi, int widx, int wcnt) {
    const int lane = threadIdx.x & 63, wave = threadIdx.x >> 6;
    LAS float* scr = (LAS float*)(lds + wave * 16384);
    unsigned char* ws = p.ws;
    for (int it = lo + widx; it < hi; it += wcnt) {
        int r = it;
        if (r < I_WIN) { const int kb = r / 53, nb = r % 53; transpose_item(p.in[3], INC, p.in[2], (bf16_t*)(ws + WS_WIN), 1024, 32 * nb, 64 * kb, 32 * nb, scr, lane); continue; } r -= I_WIN;
        if (r < I_UQ) { const int kb = r / 24, nb = r % 24; transpose_item(p.in[5], 768, p.in[4], (bf16_t*)(ws + WS_WUQ), 384, 32 * nb, 64 * kb, 32 * nb, scr, lane); continue; } r -= I_UQ;
        if (r < I_UKV) { const int kb = r / 32, nb = r % 32; transpose_item(p.in[7], 1024, p.in[6], (bf16_t*)(ws + WS_WUKV), 256, 32 * nb, 64 * kb, 32 * nb, scr, lane); continue; } r -= I_UKV;
        if (r < I_OUT) { const int kb = r / 32, nb = r % 32; const float* gn = (kb < 8) ? p.in[17] : (p.in[18] - 512); transpose_item(p.in[19], 1024, gn, (bf16_t*)(ws + WS_WOUT), 1024, 32 * nb, 64 * kb, 32 * nb, scr, lane); continue; } r -= I_OUT;
        if (r < 2 * I_G) { const int up = r >= I_G; if (up) r -= I_G; const int kb = r / 88, nb = r % 88; const int n0 = 32 * nb; const int drow = 256 * (n0 >> 7) + (n0 & 127) + (up ? 128 : 0);
            transpose_item(up ? p.in[22] : p.in[21], DFF, p.in[20], (bf16_t*)(ws + WS_WGU), 1024, drow, 64 * kb, n0, scr, lane); continue; } r -= 2 * I_G;
        { const int kb = r / 32, nb = r % 32; transpose_item(p.in[23], 1024, nullptr, (bf16_t*)(ws + WS_WDN), DFF, 32 * nb, 64 * kb, 32 * nb, scr, lane); }
    }
}
__device__ __forceinline__ void phase_prep(const Params& p, LAS unsigned char* lds) {
    const int tid = threadIdx.x, lane = tid & 63, wave = tid >> 6, G = gridDim.x;
    const int gw = blockIdx.x * 8 + wave, NGW = G * 8;
    unsigned char* ws = p.ws;
    prep_transposes(p, lds, 0, I_WIN, gw, NGW);
    { bf16_t* HB = (bf16_t*)(ws + WS_HB); float* rs1 = (float*)(ws + WS_SS) + (2 * MT + 3 * MR);
      for (int row = gw; row < MT; row += 2 * NGW) {
          const int rowB = row + NGW; const bool hasB = rowB < MT; const int rB = hasB ? rowB : row;
          const int b = row / TT, t = row % TT, b2 = rB / TT, t2 = rB % TT;
          const float* src = (t < NMETA) ? (p.in[1] + (size_t)t * DM) : (p.in[0] + ((size_t)b * SEQ + (t - NMETA)) * DM);
          const float* src2 = (t2 < NMETA) ? (p.in[1] + (size_t)t2 * DM) : (p.in[0] + ((size_t)b2 * SEQ + (t2 - NMETA)) * DM);
          f32x4 v[4], w[4]; float s = 0.f, s2 = 0.f;
#pragma unroll
          for (int j = 0; j < 4; ++j) { v[j] = __builtin_nontemporal_load((const f32x4*)src + 64 * j + lane); w[j] = __builtin_nontemporal_load((const f32x4*)src2 + 64 * j + lane); }
#pragma unroll
          for (int j = 0; j < 4; ++j) { s += (v[j][0] * v[j][0] + v[j][1] * v[j][1]) + (v[j][2] * v[j][2] + v[j][3] * v[j][3]); s2 += (w[j][0] * w[j][0] + w[j][1] * w[j][1]) + (w[j][2] * w[j][2] + w[j][3] * w[j][3]); }
          s = wave_sum(s); s2 = wave_sum(s2);
          if (lane == 0) { rs1[row] = frsq(s * (1.0f / 1024.0f) + EPS); if (hasB) rs1[rowB] = frsq(s2 * (1.0f / 1024.0f) + EPS); }
          u32x2* o8 = (u32x2*)(HB + (size_t)row * DM) + lane; u32x2* o8b = (u32x2*)(HB + (size_t)rB * DM) + lane;
#pragma unroll
          for (int j = 0; j < 4; ++j) { u32x2 x; x.x = cvt_pk(v[j][0], v[j][1]); x.y = cvt_pk(v[j][2], v[j][3]); o8[64 * j] = x; }
          if (hasB) {
#pragma unroll
              for (int j = 0; j < 4; ++j) { u32x2 x; x.x = cvt_pk(w[j][0], w[j][1]); x.y = cvt_pk(w[j][2], w[j][3]); o8b[64 * j] = x; } } } }
    const int gt = blockIdx.x * 512 + tid, NGT = G * 512;
    { float* ss = (float*)(ws + WS_SS); for (int i = gt; i < 2 * MT + 3 * MR; i += NGT) ss[i] = 0.f; }
    { u32x4* z = (u32x4*)((bf16_t*)(ws + WS_WIN) + (size_t)INC * 1024); for (int i = gt; i < (INP - INC) * 1024 / 8; i += NGT) z[i] = (u32x4){0u, 0u, 0u, 0u}; }
    { bf16_t* wl = (bf16_t*)(ws + WS_WLRU);
      for (int i = gt; i < 2 * 2 * 8 * 64 * 64; i += NGT) { const int ii = i & 63, j = (i >> 6) & 63, g = (i >> 12) & 7, which = (i >> 15) & 1, dir = (i >> 16) & 1;
          const float* src = which ? p.in[14] : p.in[12]; const float v = -1.4426950408889634f * src[((size_t)(dir * 8 + g) * 64 + ii) * 64 + j]; wl[i] = (bf16_t)(cvt_pk(v, 0.f) & 0xffffu); } }
    { bf16_t* Kb = (bf16_t*)(ws + WS_K);
      for (int i = gt; i < 128 * 576; i += NGT) { const int bh = i / 576, c = i % 576; *((u32x4*)(Kb + ((size_t)bh * TKP + TT) * QKH) + c) = (u32x4){0u, 0u, 0u, 0u}; } }
    { bf16_t* Vt = (bf16_t*)(ws + WS_VT);
      for (int i = gt; i < 128 * 64 * 6; i += NGT) { const int rowi = i / 6, c = i % 6, bh = rowi >> 6, d = rowi & 63; *((u32x4*)(Vt + ((size_t)bh * NKT + (NKT - 1)) * 4096 + d * 64 + 16) + c) = (u32x4){0u, 0u, 0u, 0u}; } }
}

#ifndef QD
#define QD 3
#endif
#define MFMA16(a, b, c) __builtin_amdgcn_mfma_f32_16x16x32_bf16((a), (b), (c), 0, 0, 0)
#define MFMA32(a, b, c) __builtin_amdgcn_mfma_f32_32x32x16_bf16((a), (b), (c), 0, 0, 0)

template <int N> __device__ __forceinline__ void wait_vm() { asm volatile("s_waitcnt vmcnt(%0)" :: "n"(N) : "memory"); }
template <int NM, int NF, int KS, int D, int LDW, int AST>
__device__ __forceinline__ void stream_gemm(const bf16_t* Wu  , unsigned voff  , const LAS bf16_t* a_lds, f32x4 (&acc)[NM][NF]) {
    static_assert(KS % D == 0, "K steps must be a multiple of the ring depth");
    bf16x8 st[D][NF];
    asm volatile("s_waitcnt vmcnt(0)" ::: "memory");
#pragma unroll
    for (int j = 0; j < D; ++j)
#pragma unroll
        for (int n = 0; n < NF; ++n) { const bf16_t* sb = Wu + (size_t)n * 16 * LDW + 32 * j; asm volatile("global_load_dwordx4 %0, %1, %2" : "=&v"(st[j][n]) : "v"(voff), "s"(sb) : "memory"); }
#pragma unroll 1
    for (int ks0 = 0; ks0 < KS; ks0 += D) {
#pragma unroll
        for (int j = 0; j < D; ++j) {
            const int ks = ks0 + j;
            wait_vm<(D - 1) * NF>();
#pragma unroll
            for (int n = 0; n < NF; ++n) asm volatile("" : "+v"(st[j][n]));
            bf16x8 af[NM];
#pragma unroll
            for (int m = 0; m < NM; ++m) af[m] = *(const LAS bf16x8*)(a_lds + (16 * m) * AST + 32 * ks);
#pragma unroll
            for (int m = 0; m < NM; ++m)
#pragma unroll
                for (int n = 0; n < NF; ++n) acc[m][n] = MFMA16(st[j][n], af[m], acc[m][n]);
            const int ksn = (ks + D < KS) ? ks + D : KS - 1;
#pragma unroll
            for (int n = 0; n < NF; ++n) { const bf16_t* sb = Wu + (size_t)n * 16 * LDW + 32 * ksn; asm volatile("global_load_dwordx4 %0, %1, %2" : "=&v"(st[j][n]) : "v"(voff), "s"(sb) : "memory"); }
        }
    }
    asm volatile("s_waitcnt vmcnt(0)" ::: "memory");
#pragma unroll
    for (int j = 0; j < D; ++j)
#pragma unroll
        for (int n = 0; n < NF; ++n) asm volatile("" : "+v"(st[j][n]));
}
template <int NM>
__device__ __forceinline__ void qkv_unit(const Params& p, LAS unsigned char* lds, int r0) {
    int tid_ = threadIdx.x; asm volatile("" : "+v"(tid_));
    const int tid = tid_, lane = tid & 63, h = tid >> 6, fr = lane & 15, fq = lane >> 4;
    const int hs = __builtin_amdgcn_readfirstlane(h);
    unsigned char* ws = p.ws;
    const bf16_t* P = (const bf16_t*)(ws + WS_P);
    const float* ss_cq = (const float*)(ws + WS_SS); const float* ss_ckv = ss_cq + MT;
    constexpr int CQS = 392, CKS = 264;
    LAS bf16_t* cq = (LAS bf16_t*)lds; LAS bf16_t* ckv = (LAS bf16_t*)(lds + 64 * CQS * 2);
    LAS bf16_t* stg = (LAS bf16_t*)(lds + 83968 + h * 3328);
    __syncthreads();
    for (int idx = tid; idx < 16 * NM * 48; idx += 512) { const int r = idx / 48, c = idx % 48; *(LAS u32x4*)(cq + r * CQS + c * 8) = *(const u32x4*)(P + (size_t)(r0 + r) * INP + c * 8); }
    for (int idx = tid; idx < 16 * NM * 32; idx += 512) { const int r = idx / 32, c = idx % 32; *(LAS u32x4*)(ckv + r * CKS + c * 8) = *(const u32x4*)(P + (size_t)(r0 + r) * INP + C_CKV + c * 8); }
    __syncthreads();
    {
        const bf16_t* W = (const bf16_t*)(ws + WS_WUQ) + (size_t)(96 * hs) * 384; const unsigned wv = (unsigned)(fr * 384 + 8 * fq) * 2u;
        f32x4 acc[NM][6];
#pragma unroll
        for (int m = 0; m < NM; ++m)
#pragma unroll
            for (int n = 0; n < 6; ++n) acc[m][n] = (f32x4){0.f, 0.f, 0.f, 0.f};
        stream_gemm<NM, 6, 12, 3, 384, CQS>(W, wv, cq + fr * CQS + 8 * fq, acc);
        const float* qg = p.in[8];
        bf16_t* Q = (bf16_t*)(ws + WS_Q);
        float ssv[NM]; f32x4 gvv[6];
#pragma unroll
        for (int m = 0; m < NM; ++m) ssv[m] = ss_cq[r0 + 16 * m + fr];
#pragma unroll
        for (int n = 0; n < 6; ++n) gvv[n] = *(const f32x4*)(qg + 16 * n + 4 * fq);
        float frq[4];
#pragma unroll
        for (int i = 0; i < 4; ++i) frq[i] = exp2f(-(float)(4 * fq + i) * (13.287712379549449f / 16.0f));
#pragma unroll 1
        for (int mi = 0; mi < NM; ++mi) {
            const int row = r0 + 16 * mi + fr, t = row % TT;
            const float sc = frsq(ssv[0] * (1.0f / 384.0f) + EPS);
            float ssq = 0.f;
#pragma unroll
            for (int n = 0; n < 6; ++n) { acc[0][n] *= sc; ssq += (acc[0][n][0] * acc[0][n][0] + acc[0][n][1] * acc[0][n][1]) + (acc[0][n][2] * acc[0][n][2] + acc[0][n][3] * acc[0][n][3]); }
            ssq += __shfl_xor(ssq, 16); ssq += __shfl_xor(ssq, 32);
            const float rq = frsq(ssq * (1.0f / 96.0f) + EPS);
#pragma unroll
            for (int n = 0; n < 6; ++n) acc[0][n] = acc[0][n] * rq * gvv[n];
#pragma unroll
            for (int i = 0; i < 4; ++i) { float sn, cs; sincos_rr((float)t * frq[i], sn, cs);
                const float x1 = acc[0][4][i], x2 = acc[0][5][i]; acc[0][4][i] = x1 * cs - x2 * sn; acc[0][5][i] = x1 * sn + x2 * cs; }
#pragma unroll
            for (int n = 0; n < 6; ++n) { u32x2 w; w.x = cvt_pk(acc[0][n][0] * QSCALE, acc[0][n][1] * QSCALE); w.y = cvt_pk(acc[0][n][2] * QSCALE, acc[0][n][3] * QSCALE); *(LAS u32x2*)(stg + fr * 104 + 16 * n + 4 * fq) = w; }
            asm volatile("s_waitcnt lgkmcnt(0)" ::: "memory");
#pragma unroll
            for (int j = 0; j < 3; ++j) { const int c = lane + 64 * j, rw = c / 12, cc = c % 12; const int row2 = r0 + 16 * mi + rw, b2 = row2 / TT, t2 = row2 % TT;
                const u32x4 v = *(const LAS u32x4*)(stg + rw * 104 + 8 * cc);
                if (t2 >= NMETA) *(u32x4*)(Q + (((size_t)(b2 * NH + h)) * SEQ + (t2 - NMETA)) * QKH + 8 * cc) = v; }
            asm volatile("s_waitcnt lgkmcnt(0)" ::: "memory");
            if constexpr (NM == 4) {
#pragma unroll
            for (int n = 0; n < 6; ++n) { acc[0][n] = acc[1][n]; acc[1][n] = acc[2][n]; acc[2][n] = acc[3][n]; }
            ssv[0] = ssv[1]; ssv[1] = ssv[2]; ssv[2] = ssv[3]; }
        }
    }
    {
        const bf16_t* W = (const bf16_t*)(ws + WS_WUKV) + (size_t)(128 * hs) * 256; const unsigned wv = (unsigned)(fr * 256 + 8 * fq) * 2u;
        f32x4 acc[NM][4];
#pragma unroll
        for (int m = 0; m < NM; ++m)
#pragma unroll
            for (int n = 0; n < 4; ++n) acc[m][n] = (f32x4){0.f, 0.f, 0.f, 0.f};
        stream_gemm<NM, 4, 8, 4, 256, CKS>(W, wv, ckv + fr * CKS + 8 * fq, acc);
        const float* kg = p.in[9];
        bf16_t* Kb = (bf16_t*)(ws + WS_K);
        float ssv[NM]; u32x2 k1v[NM], k2v[NM]; f32x4 gvv[6];
#pragma unroll
        for (int m = 0; m < NM; ++m) { const int row = r0 + 16 * m + fr; ssv[m] = ss_ckv[row]; k1v[m] = *(const u32x2*)(P + (size_t)row * INP + C_KR + 4 * fq); k2v[m] = *(const u32x2*)(P + (size_t)row * INP + C_KR + 16 + 4 * fq); }
#pragma unroll
        for (int n = 0; n < 6; ++n) gvv[n] = *(const f32x4*)(kg + 16 * n + 4 * fq);
        float frq[4];
#pragma unroll
        for (int i = 0; i < 4; ++i) frq[i] = exp2f(-(float)(4 * fq + i) * (13.287712379549449f / 16.0f));
#pragma unroll
        for (int mi = 0; mi < NM; ++mi) {
            const int row = r0 + 16 * mi + fr, t = row % TT;
            const float sc = frsq(ssv[mi] * (1.0f / 256.0f) + EPS);
            const u32x2 k1 = k1v[mi], k2 = k2v[mi];
            f32x4 kr1 = (f32x4){bflo(k1.x), bfhi(k1.x), bflo(k1.y), bfhi(k1.y)}, kr2 = (f32x4){bflo(k2.x), bfhi(k2.x), bflo(k2.y), bfhi(k2.y)};
            float ssq = (kr1[0] * kr1[0] + kr1[1] * kr1[1]) + (kr1[2] * kr1[2] + kr1[3] * kr1[3]) + (kr2[0] * kr2[0] + kr2[1] * kr2[1]) + (kr2[2] * kr2[2] + kr2[3] * kr2[3]);
#pragma unroll
            for (int n = 0; n < 4; ++n) { acc[mi][n] *= sc; ssq += (acc[mi][n][0] * acc[mi][n][0] + acc[mi][n][1] * acc[mi][n][1]) + (acc[mi][n][2] * acc[mi][n][2] + acc[mi][n][3] * acc[mi][n][3]); }
            ssq += __shfl_xor(ssq, 16); ssq += __shfl_xor(ssq, 32);
            const float rk = frsq(ssq * (1.0f / 96.0f) + EPS);
            LAS bf16_t* dstk = stg + fr * 104 + 4 * fq;
#pragma unroll
            for (int n = 0; n < 4; ++n) { const f32x4 v = acc[mi][n] * rk * gvv[n]; u32x2 w; w.x = cvt_pk(v[0], v[1]); w.y = cvt_pk(v[2], v[3]); *(LAS u32x2*)(dstk + 16 * n) = w; }
            { kr1 = kr1 * rk * gvv[4]; kr2 = kr2 * rk * gvv[5];
              f32x4 o1, o2;
#pragma unroll
              for (int i = 0; i < 4; ++i) { float sn, cs; sincos_rr((float)t * frq[i], sn, cs);
                  o1[i] = kr1[i] * cs - kr2[i] * sn; o2[i] = kr1[i] * sn + kr2[i] * cs; }
              u32x2 w; w.x = cvt_pk(o1[0], o1[1]); w.y = cvt_pk(o1[2], o1[3]); *(LAS u32x2*)(dstk + 64) = w; w.x = cvt_pk(o2[0], o2[1]); w.y = cvt_pk(o2[2], o2[3]); *(LAS u32x2*)(dstk + 80) = w; }
            asm volatile("s_waitcnt lgkmcnt(0)" ::: "memory");
#pragma unroll
            for (int j = 0; j < 3; ++j) { const int c = lane + 64 * j, rw = c / 12, cc = c % 12; const int row2 = r0 + 16 * mi + rw, b2 = row2 / TT, t2 = row2 % TT;
                const u32x4 v = *(const LAS u32x4*)(stg + rw * 104 + 8 * cc);
                *(u32x4*)(Kb + (((size_t)(b2 * NH + h)) * TKP + t2) * QKH + 8 * cc) = v; }
            asm volatile("s_waitcnt lgkmcnt(0)" ::: "memory"); __builtin_amdgcn_sched_barrier(0);
        }
    }
    {
        const bf16_t* W = (const bf16_t*)(ws + WS_WUKV) + (size_t)(128 * hs + 64) * 256; const unsigned wv = (unsigned)(fr * 256 + 8 * fq) * 2u;
        f32x4 acc[NM][4];
#pragma unroll
        for (int m = 0; m < NM; ++m)
#pragma unroll
            for (int n = 0; n < 4; ++n) acc[m][n] = (f32x4){0.f, 0.f, 0.f, 0.f};
        stream_gemm<NM, 4, 8, 4, 256, CKS>(W, wv, ckv + fr * CKS + 8 * fq, acc);
        bf16_t* Vt = (bf16_t*)(ws + WS_VT);
        float ssv[NM];
#pragma unroll
        for (int m = 0; m < NM; ++m) ssv[m] = ss_ckv[r0 + 16 * m + fr];
#pragma unroll
        for (int mi = 0; mi < NM; ++mi) {
            const float sc = frsq(ssv[mi] * (1.0f / 256.0f) + EPS);
#pragma unroll
            for (int n = 0; n < 4; ++n)
#pragma unroll
                for (int i = 0; i < 4; ++i) { const int d = 16 * n + 4 * fq + i; stg[d * 16 + fr] = (bf16_t)(cvt_pk(acc[mi][n][i] * sc, 0.f) & 0xffffu); }
            asm volatile("s_waitcnt lgkmcnt(0)" ::: "memory");
            { const int row2 = r0 + 16 * mi, b2 = row2 / TT, t2 = row2 % TT;
              bf16_t* dstv = Vt + (((size_t)(b2 * NH + h)) * NKT + (t2 >> 6)) * 4096 + (t2 & 63);
#pragma unroll
              for (int j = 0; j < 2; ++j) { const int c = lane + 64 * j, d = c >> 1, hf = c & 1; *(u32x4*)(dstv + d * 64 + 8 * hf) = *(const LAS u32x4*)(stg + d * 16 + 8 * hf); } }
            asm volatile("s_waitcnt lgkmcnt(0)" ::: "memory"); __builtin_amdgcn_sched_barrier(0);
        }
    }
}

__device__ __forceinline__ void qkv_head_unit(const Params& p, LAS unsigned char* lds, int h, int blk_begin, int blk_end) {
    int tid_ = threadIdx.x; asm volatile("" : "+v"(tid_));
    const int tid = tid_, lane = tid & 63, w = tid >> 6, fr = lane & 15, fq = lane >> 4;
    unsigned char* ws = p.ws;
    const bf16_t* P = (const bf16_t*)(ws + WS_P);
    const float* ss_cq = (const float*)(ws + WS_SS); const float* ss_ckv = ss_cq + MT;
    constexpr int WQS = 392, WKS = 264;
    LAS bf16_t* wl = (LAS bf16_t*)lds;
    LAS bf16_t* stg = (LAS bf16_t*)(lds + 83968 + w * 3328);
    float frq[4];
#pragma unroll
    for (int i = 0; i < 4; ++i) frq[i] = exp2f(-(float)(4 * fq + i) * (13.287712379549449f / 16.0f));
    __syncthreads();
    { const bf16_t* W = (const bf16_t*)(ws + WS_WUQ) + (size_t)(96 * h) * 384;
      for (int idx = tid; idx < 96 * 48; idx += 512) { const int r = idx / 48, c = idx % 48; *(LAS u32x4*)(wl + r * WQS + c * 8) = *(const u32x4*)(W + r * 384 + c * 8); } }
    __syncthreads();
    {
        bf16_t* Q = (bf16_t*)(ws + WS_Q);
        f32x4 gvv[6];
#pragma unroll
        for (int n = 0; n < 6; ++n) gvv[n] = *(const f32x4*)(p.in[8] + 16 * n + 4 * fq);
#pragma unroll 1
        for (int pb = blk_begin + 2 * w; pb < blk_end; pb += 16) {
            const bool two = (pb + 1) < blk_end;
            const int blk1 = two ? pb + 1 : pb;
            const int rowm[2] = {16 * pb + fr, 16 * blk1 + fr};
            bf16x8 af[2][12]; float ssv[2];
#pragma unroll
            for (int m = 0; m < 2; ++m) { ssv[m] = ss_cq[rowm[m]];
#pragma unroll
                for (int ks = 0; ks < 12; ++ks) af[m][ks] = *(const bf16x8*)(P + (size_t)rowm[m] * INP + 32 * ks + 8 * fq); }
            f32x4 acc[2][6];
#pragma unroll
            for (int m = 0; m < 2; ++m)
#pragma unroll
                for (int n = 0; n < 6; ++n) acc[m][n] = (f32x4){0.f, 0.f, 0.f, 0.f};
#pragma unroll
            for (int ks = 0; ks < 12; ++ks)
#pragma unroll
                for (int n = 0; n < 6; ++n) { const bf16x8 bw = *(const LAS bf16x8*)(wl + (16 * n + fr) * WQS + 32 * ks + 8 * fq);
                    acc[0][n] = MFMA16(bw, af[0][ks], acc[0][n]); acc[1][n] = MFMA16(bw, af[1][ks], acc[1][n]); }
#pragma unroll
            for (int mi = 0; mi < 2; ++mi) {
                const bool valid = (mi == 0) || two;
                const int t = rowm[mi] % TT;
                const float sc = frsq(ssv[mi] * (1.0f / 384.0f) + EPS);
                float ssq = 0.f;
#pragma unroll
                for (int n = 0; n < 6; ++n) { acc[mi][n] *= sc; ssq += (acc[mi][n][0] * acc[mi][n][0] + acc[mi][n][1] * acc[mi][n][1]) + (acc[mi][n][2] * acc[mi][n][2] + acc[mi][n][3] * acc[mi][n][3]); }
                ssq += __shfl_xor(ssq, 16); ssq += __shfl_xor(ssq, 32);
                const float rq = frsq(ssq * (1.0f / 96.0f) + EPS);
#pragma unroll
                for (int n = 0; n < 6; ++n) acc[mi][n] = acc[mi][n] * rq * gvv[n];
#pragma unroll
                for (int i = 0; i < 4; ++i) { float sn, cs; sincos_rr((float)t * frq[i], sn, cs);
                    const float x1 = acc[mi][4][i], x2 = acc[mi][5][i]; acc[mi][4][i] = x1 * cs - x2 * sn; acc[mi][5][i] = x1 * sn + x2 * cs; }
#pragma unroll
                for (int n = 0; n < 6; ++n) { u32x2 wv; wv.x = cvt_pk(acc[mi][n][0] * QSCALE, acc[mi][n][1] * QSCALE); wv.y = cvt_pk(acc[mi][n][2] * QSCALE, acc[mi][n][3] * QSCALE); *(LAS u32x2*)(stg + fr * 104 + 16 * n + 4 * fq) = wv; }
                asm volatile("s_waitcnt lgkmcnt(0)" ::: "memory");
#pragma unroll
                for (int j = 0; j < 3; ++j) { const int c = lane + 64 * j, rw = c / 12, cc = c % 12; const int row2 = 16 * (mi ? blk1 : pb) + rw, b2 = row2 / TT, t2 = row2 % TT;
                    const u32x4 v = *(const LAS u32x4*)(stg + rw * 104 + 8 * cc);
                    if (valid && t2 >= NMETA) *(u32x4*)(Q + (((size_t)(b2 * NH + h)) * SEQ + (t2 - NMETA)) * QKH + 8 * cc) = v; }
                asm volatile("s_waitcnt lgkmcnt(0)" ::: "memory"); __builtin_amdgcn_sched_barrier(0);
            }
        }
    }
    __syncthreads();
    { const bf16_t* W = (const bf16_t*)(ws + WS_WUKV) + (size_t)(128 * h) * 256;
      for (int idx = tid; idx < 128 * 32; idx += 512) { const int r = idx / 32, c = idx % 32; *(LAS u32x4*)(wl + r * WKS + c * 8) = *(const u32x4*)(W + r * 256 + c * 8); } }
    __syncthreads();
    {
        bf16_t* Kb = (bf16_t*)(ws + WS_K); bf16_t* Vt = (bf16_t*)(ws + WS_VT);
        f32x4 gvv[6];
#pragma unroll
        for (int n = 0; n < 6; ++n) gvv[n] = *(const f32x4*)(p.in[9] + 16 * n + 4 * fq);
#pragma unroll 1
        for (int pb = blk_begin + 2 * w; pb < blk_end; pb += 16) {
            const bool two = (pb + 1) < blk_end;
            const int blk1 = two ? pb + 1 : pb;
            const int rowm[2] = {16 * pb + fr, 16 * blk1 + fr};
            bf16x8 af[2][8]; float ssv[2]; u32x2 k1v[2], k2v[2];
#pragma unroll
            for (int m = 0; m < 2; ++m) { ssv[m] = ss_ckv[rowm[m]]; k1v[m] = *(const u32x2*)(P + (size_t)rowm[m] * INP + C_KR + 4 * fq); k2v[m] = *(const u32x2*)(P + (size_t)rowm[m] * INP + C_KR + 16 + 4 * fq);
#pragma unroll
                for (int ks = 0; ks < 8; ++ks) af[m][ks] = *(const bf16x8*)(P + (size_t)rowm[m] * INP + C_CKV + 32 * ks + 8 * fq); }
            {
                f32x4 acc[2][4];
#pragma unroll
                for (int m = 0; m < 2; ++m)
#pragma unroll
                    for (int n = 0; n < 4; ++n) acc[m][n] = (f32x4){0.f, 0.f, 0.f, 0.f};
#pragma unroll
                for (int ks = 0; ks < 8; ++ks)
#pragma unroll
                    for (int n = 0; n < 4; ++n) { const bf16x8 bw = *(const LAS bf16x8*)(wl + (16 * n + fr) * WKS + 32 * ks + 8 * fq);
                        acc[0][n] = MFMA16(bw, af[0][ks], acc[0][n]); acc[1][n] = MFMA16(bw, af[1][ks], acc[1][n]); }
#pragma unroll
                for (int mi = 0; mi < 2; ++mi) {
                    const bool valid = (mi == 0) || two;
                    const int t = rowm[mi] % TT;
                    const float sc = frsq(ssv[mi] * (1.0f / 256.0f) + EPS);
                    const u32x2 k1 = k1v[mi], k2 = k2v[mi];
                    f32x4 kr1 = (f32x4){bflo(k1.x), bfhi(k1.x), bflo(k1.y), bfhi(k1.y)}, kr2 = (f32x4){bflo(k2.x), bfhi(k2.x), bflo(k2.y), bfhi(k2.y)};
                    float ssq = (kr1[0] * kr1[0] + kr1[1] * kr1[1]) + (kr1[2] * kr1[2] + kr1[3] * kr1[3]) + (kr2[0] * kr2[0] + kr2[1] * kr2[1]) + (kr2[2] * kr2[2] + kr2[3] * kr2[3]);
#pragma unroll
                    for (int n = 0; n < 4; ++n) { acc[mi][n] *= sc; ssq += (acc[mi][n][0] * acc[mi][n][0] + acc[mi][n][1] * acc[mi][n][1]) + (acc[mi][n][2] * acc[mi][n][2] + acc[mi][n][3] * acc[mi][n][3]); }
                    ssq += __shfl_xor(ssq, 16); ssq += __shfl_xor(ssq, 32);
                    const float rk = frsq(ssq * (1.0f / 96.0f) + EPS);
                    LAS bf16_t* dstk = stg + fr * 104 + 4 * fq;
#pragma unroll
                    for (int n = 0; n < 4; ++n) { const f32x4 v = acc[mi][n] * rk * gvv[n]; u32x2 wv; wv.x = cvt_pk(v[0], v[1]); wv.y = cvt_pk(v[2], v[3]); *(LAS u32x2*)(dstk + 16 * n) = wv; }
                    { kr1 = kr1 * rk * gvv[4]; kr2 = kr2 * rk * gvv[5];
                      f32x4 o1, o2;
#pragma unroll
                      for (int i = 0; i < 4; ++i) { float sn, cs; sincos_rr((float)t * frq[i], sn, cs);
                          o1[i] = kr1[i] * cs - kr2[i] * sn; o2[i] = kr1[i] * sn + kr2[i] * cs; }
                      u32x2 wv; wv.x = cvt_pk(o1[0], o1[1]); wv.y = cvt_pk(o1[2], o1[3]); *(LAS u32x2*)(dstk + 64) = wv; wv.x = cvt_pk(o2[0], o2[1]); wv.y = cvt_pk(o2[2], o2[3]); *(LAS u32x2*)(dstk + 80) = wv; }
                    asm volatile("s_waitcnt lgkmcnt(0)" ::: "memory");
#pragma unroll
                    for (int j = 0; j < 3; ++j) { const int c = lane + 64 * j, rw = c / 12, cc = c % 12; const int row2 = 16 * (mi ? blk1 : pb) + rw, b2 = row2 / TT, t2 = row2 % TT;
                        const u32x4 v = *(const LAS u32x4*)(stg + rw * 104 + 8 * cc);
                        if (valid) *(u32x4*)(Kb + (((size_t)(b2 * NH + h)) * TKP + t2) * QKH + 8 * cc) = v; }
                    asm volatile("s_waitcnt lgkmcnt(0)" ::: "memory"); __builtin_amdgcn_sched_barrier(0);
                }
            }
            {
                f32x4 acc[2][4];
#pragma unroll
                for (int m = 0; m < 2; ++m)
#pragma unroll
                    for (int n = 0; n < 4; ++n) acc[m][n] = (f32x4){0.f, 0.f, 0.f, 0.f};
#pragma unroll
                for (int ks = 0; ks < 8; ++ks)
#pragma unroll
                    for (int n = 0; n < 4; ++n) { const bf16x8 bw = *(const LAS bf16x8*)(wl + (64 + 16 * n + fr) * WKS + 32 * ks + 8 * fq);
                        acc[0][n] = MFMA16(bw, af[0][ks], acc[0][n]); acc[1][n] = MFMA16(bw, af[1][ks], acc[1][n]); }
#pragma unroll
                for (int mi = 0; mi < 2; ++mi) {
                    const bool valid = (mi == 0) || two;
                    const float sc = frsq(ssv[mi] * (1.0f / 256.0f) + EPS);
#pragma unroll
                    for (int n = 0; n < 4; ++n)
#pragma unroll
                        for (int i = 0; i < 4; ++i) { const int d = 16 * n + 4 * fq + i; stg[d * 16 + fr] = (bf16_t)(cvt_pk(acc[mi][n][i] * sc, 0.f) & 0xffffu); }
                    asm volatile("s_waitcnt lgkmcnt(0)" ::: "memory");
                    { const int row2 = 16 * (mi ? blk1 : pb), b2 = row2 / TT, t2 = row2 % TT;
                      bf16_t* dstv = Vt + (((size_t)(b2 * NH + h)) * NKT + (t2 >> 6)) * 4096 + (t2 & 63);
#pragma unroll
                      for (int j = 0; j < 2; ++j) { const int c = lane + 64 * j, d = c >> 1, hf = c & 1; if (valid) *(u32x4*)(dstv + d * 64 + 8 * hf) = *(const LAS u32x4*)(stg + d * 16 + 8 * hf); } }
                    asm volatile("s_waitcnt lgkmcnt(0)" ::: "memory"); __builtin_amdgcn_sched_barrier(0);
                }
            }
        }
    }
}

#define LDS_BARRIER() asm volatile("s_waitcnt lgkmcnt(0)\n\ts_barrier" ::: "memory")
__device__ __forceinline__ float fsig(float x) { return __builtin_amdgcn_rcpf(1.0f + __builtin_amdgcn_exp2f(-1.4426950408889634f * x)); }
template <int DIR>
__device__ __forceinline__ void rnn_scan_unit(const Params& p, LAS unsigned char* lds, int b, int g) {
    int tid_ = threadIdx.x; asm volatile("" : "+v"(tid_));
    const int tid = tid_, lane = tid & 63, wid = tid >> 6, fr = lane & 15, fq = lane >> 4;
    unsigned char* ws = p.ws;
    const bf16_t* P = (const bf16_t*)(ws + WS_P);
    bf16_t* H = (bf16_t*)(ws + WS_H) + (size_t)DIR * MT * 512;
    constexpr int XS = 68;
    LAS unsigned char* wb = lds + wid * 14976;
    LAS bf16_t* xrb = (LAS bf16_t*)wb;
    LAS float* xcf = (LAS float*)(wb + 2432);
    LAS float* al = (LAS float*)(wb + 2432 + 4352);
    LAS float* bl = (LAS float*)(wb + 2432 + 4352 + 4096);
    LAS float* sg = (LAS float*)(lds + 8 * 14976);
    LAS bf16x8* wl = (LAS bf16x8*)(lds + 8 * 14976 + 8192);
    LAS float* cst = (LAS float*)(lds + 8 * 14976 + 8192 + 16384);
    __syncthreads();
    { const bf16_t* Wl = (const bf16_t*)(ws + WS_WLRU);
#pragma unroll
      for (int i = 0; i < 2; ++i) { const int f = wid * 2 + i, which = f >> 3, n = (f >> 1) & 3, ks = f & 1;
          wl[f * 64 + lane] = *(const bf16x8*)(Wl + ((size_t)((DIR * 2 + which) * 8 + g) * 64 + 16 * n + fr) * 64 + 32 * ks + 8 * fq); }
      if (tid < 64) { const int c = DIR * 512 + 64 * g + tid; cst[tid] = -1.4426950408889634f * p.in[13][c]; cst[64 + tid] = -1.4426950408889634f * p.in[15][c]; cst[128 + tid] = -8.0f * 1.4426950408889634f * log1pf(__expf(-p.in[16][c])); } }
    const int ch = lane, seg = wid;
    LDS_BARRIER();
    bf16x8 wreg[8];
#pragma unroll
    for (int f = 0; f < 8; ++f) wreg[f] = wl[f * 64 + lane];
    f32x4 cwv[4][2], cbv[2];
    { const int c0 = 64 * g + 8 * (lane & 7);
#pragma unroll
      for (int j = 0; j < 4; ++j) { cwv[j][0] = *(const f32x4*)(p.in[10] + j * 512 + c0); cwv[j][1] = *(const f32x4*)(p.in[10] + j * 512 + c0 + 4); }
      cbv[0] = *(const f32x4*)(p.in[11] + c0); cbv[1] = *(const f32x4*)(p.in[11] + c0 + 4); }
    float hcar = 0.f;
    u32x4 xw[3];
#define XR_LOAD(ckv) do { const int tb_ = 128 * (ckv) + 16 * wid - 2; _Pragma("unroll") for (int i = 0; i < 3; ++i) { const int idx = lane + 64 * i, r = idx >> 3, c8 = idx & 7, t = tb_ + r; \
        xw[i] = (u32x4){0u, 0u, 0u, 0u}; if (idx < 152 && t >= 0 && t < TT) xw[i] = *(const u32x4*)(P + ((size_t)b * TT + t) * INP + C_XR + 64 * g + 8 * c8); } } while (0)
    XR_LOAD(DIR == 0 ? 0 : NCH - 1);
#pragma unroll 1
    for (int ci = 0; ci < NCH; ++ci) {
        const int ck = DIR == 0 ? ci : NCH - 1 - ci, t0 = 128 * ck + 16 * wid;
#pragma unroll
        for (int i = 0; i < 3; ++i) { const int idx = lane + 64 * i; if (idx < 152) *(LAS u32x4*)(xrb + idx * 8) = xw[i]; }
        asm volatile("s_waitcnt lgkmcnt(0)" ::: "memory");
        if (ci + 1 < NCH) XR_LOAD(DIR == 0 ? ci + 1 : NCH - 2 - ci);
        { const int tl0 = lane >> 3, c8 = lane & 7;
#pragma unroll
          for (int hh = 0; hh < 2; ++hh) { const int tl = tl0 + 8 * hh;
              f32x4 o0 = cbv[0], o1 = cbv[1];
#pragma unroll
              for (int j = 0; j < 4; ++j) { const u32x4 xw_ = *(const LAS u32x4*)(xrb + (tl + j) * 64 + 8 * c8);
                  o0[0] += cwv[j][0][0] * bflo(xw_.x); o0[1] += cwv[j][0][1] * bfhi(xw_.x); o0[2] += cwv[j][0][2] * bflo(xw_.y); o0[3] += cwv[j][0][3] * bfhi(xw_.y);
                  o1[0] += cwv[j][1][0] * bflo(xw_.z); o1[1] += cwv[j][1][1] * bfhi(xw_.z); o1[2] += cwv[j][1][2] * bflo(xw_.w); o1[3] += cwv[j][1][3] * bfhi(xw_.w); }
              *(LAS f32x4*)(xcf + tl * XS + 8 * c8) = o0; *(LAS f32x4*)(xcf + tl * XS + 8 * c8 + 4) = o1; } }
        asm volatile("s_waitcnt lgkmcnt(0)" ::: "memory");
        { const int tt = fr; const bool valid = (t0 + tt) < TT;
          bf16x8 af[2];
#pragma unroll
          for (int ks = 0; ks < 2; ++ks) { const f32x4 x0 = *(const LAS f32x4*)(xcf + tt * XS + 32 * ks + 8 * fq), x1 = *(const LAS f32x4*)(xcf + tt * XS + 32 * ks + 8 * fq + 4);
              u32x4 w; w.x = cvt_pk(x0[0], x0[1]); w.y = cvt_pk(x0[2], x0[3]); w.z = cvt_pk(x1[0], x1[1]); w.w = cvt_pk(x1[2], x1[3]); af[ks] = __builtin_bit_cast(bf16x8, w); }
#pragma unroll
          for (int n = 0; n < 4; ++n) { const int c4 = 16 * n + 4 * fq;
              f32x4 ra = *(const LAS f32x4*)(cst + c4), ia = *(const LAS f32x4*)(cst + 64 + c4);
#pragma unroll
              for (int ks = 0; ks < 2; ++ks) { ra = MFMA16(wreg[(0 * 4 + n) * 2 + ks], af[ks], ra); ia = MFMA16(wl[((1 * 4 + n) * 2 + ks) * 64 + lane], af[ks], ia); }
              const f32x4 xv = *(const LAS f32x4*)(xcf + tt * XS + c4);
              const f32x4 spv = *(const LAS f32x4*)(cst + 128 + c4);
              f32x4 av, bv;
#pragma unroll
              for (int i = 0; i < 4; ++i) { const float r = __builtin_amdgcn_rcpf(1.0f + __builtin_amdgcn_exp2f(ra[i])), ig = __builtin_amdgcn_rcpf(1.0f + __builtin_amdgcn_exp2f(ia[i]));
                  const float a = __builtin_amdgcn_exp2f(r * spv[i]); const float em = fmaf(-a, a, 1.0f);
                  av[i] = valid ? a : 1.0f; bv[i] = valid ? __builtin_amdgcn_sqrtf(fmaxf(em, 0.0f)) * ig * xv[i] : 0.0f; }
              *(LAS f32x4*)(al + tt * 64 + c4) = av; *(LAS f32x4*)(bl + tt * 64 + c4) = bv; } }
        asm volatile("s_waitcnt lgkmcnt(0)" ::: "memory");
        LAS float* sgA = sg + (ci & 1) * 1024; LAS float* sgB = sgA + 512;
        float av_[16], bv_[16];
        { float A = 1.f, B = 0.f;
#pragma unroll
          for (int k = 0; k < 16; ++k) { const int tt = DIR == 0 ? k : 15 - k; av_[k] = al[tt * 64 + ch]; bv_[k] = bl[tt * 64 + ch]; B = av_[k] * B + bv_[k]; A *= av_[k]; }
          sgA[seg * 64 + ch] = A; sgB[seg * 64 + ch] = B; }
        LDS_BARRIER();
        float h = hcar, hin = hcar;
#pragma unroll
        for (int s = 0; s < 8; ++s) { const int sx = DIR == 0 ? s : 7 - s; hin = (sx == seg) ? h : hin; h = sgA[sx * 64 + ch] * h + sgB[sx * 64 + ch]; }
        hcar = h;
#pragma unroll
        for (int k = 0; k < 16; ++k) { const int tt = DIR == 0 ? k : 15 - k; hin = av_[k] * hin + bv_[k]; bl[tt * 64 + ch] = hin; }
        asm volatile("s_waitcnt lgkmcnt(0)" ::: "memory");
        { const int tk = lane >> 2, cq4 = lane & 3;
          if (t0 + tk < TT) { const LAS float* src = bl + tk * 64 + 16 * cq4;
              const f32x4 x0 = *(const LAS f32x4*)(src), x1 = *(const LAS f32x4*)(src + 4), x2 = *(const LAS f32x4*)(src + 8), x3 = *(const LAS f32x4*)(src + 12);
              u32x4 w0, w1; w0.x = cvt_pk(x0[0], x0[1]); w0.y = cvt_pk(x0[2], x0[3]); w0.z = cvt_pk(x1[0], x1[1]); w0.w = cvt_pk(x1[2], x1[3]);
              w1.x = cvt_pk(x2[0], x2[1]); w1.y = cvt_pk(x2[2], x2[3]); w1.z = cvt_pk(x3[0], x3[1]); w1.w = cvt_pk(x3[2], x3[3]);
              bf16_t* hp = H + ((size_t)b * TT + t0 + tk) * 512 + 64 * g + 16 * cq4;
              *(u32x4*)hp = w0; *(u32x4*)(hp + 8) = w1; } }
        asm volatile("s_waitcnt lgkmcnt(0)" ::: "memory");
    }
#undef XR_LOAD
    __syncthreads();
}
__device__ __forceinline__ void rnn_combine(const Params& p) {
    const int tid = threadIdx.x, lane = tid & 63, wave = tid >> 6;
    unsigned char* ws = p.ws;
    const bf16_t* P = (const bf16_t*)(ws + WS_P); const bf16_t* H0 = (const bf16_t*)(ws + WS_H); const bf16_t* H1 = H0 + (size_t)MT * 512;
    bf16_t* MIX = (bf16_t*)(ws + WS_MIX); float* ss_b = (float*)(ws + WS_SS) + 2 * MT + MR;
    const int NW = gridDim.x * 8;
    for (int r0 = blockIdx.x * 8 + wave; r0 < MR; r0 += 4 * NW) {
        u32x4 hf[4], hb[4], gw[4];
#pragma unroll
        for (int k = 0; k < 4; ++k) { const int rr = (r0 + k * NW < MR) ? r0 + k * NW : r0; const int b = rr / SEQ, sidx = rr % SEQ; const size_t src = (size_t)b * TT + sidx + NMETA;
            hf[k] = *(const u32x4*)(H0 + src * 512 + 8 * lane); hb[k] = *(const u32x4*)(H1 + src * 512 + 8 * lane); gw[k] = *(const u32x4*)(P + src * INP + C_GATE + 8 * lane); }
#pragma unroll
        for (int k = 0; k < 4; ++k) { const int rr = r0 + k * NW;
            float y[8]; float q = 0.f;
#pragma unroll
            for (int i = 0; i < 4; ++i) { const unsigned a = hf[k][i], c = hb[k][i], gg = gw[k][i];
#pragma unroll
                for (int e = 0; e < 2; ++e) { const float hs = (e ? bfhi(a) : bflo(a)) + (e ? bfhi(c) : bflo(c)); const float gt = e ? bfhi(gg) : bflo(gg);
                    const float u = 0.7978845608028654f * (gt + 0.044715f * gt * gt * gt); const float th = 1.0f - 2.0f * __builtin_amdgcn_rcpf(1.0f + __builtin_amdgcn_exp2f(2.8853900817779268f * u));
                    const float yv = hs * (0.5f * gt * (1.0f + th)); y[2 * i + e] = yv; q += yv * yv; } }
            q = wave_sum(q);
            if (rr < MR) { u32x4 w; w.x = cvt_pk(y[0], y[1]); w.y = cvt_pk(y[2], y[3]); w.z = cvt_pk(y[4], y[5]); w.w = cvt_pk(y[6], y[7]);
                *(u32x4*)(MIX + (size_t)rr * DM + 512 + 8 * lane) = w;
                if (lane == 0) ss_b[rr] = q; } }
    }
}

__device__ __forceinline__ void attn_unit(const Params& p, LAS unsigned char* lds, int bh, int qb) {
    int tid_ = threadIdx.x; asm volatile("" : "+v"(tid_));
    const int tid = tid_, lane = tid & 63, wid = tid >> 6, l31 = lane & 31, hi = lane >> 5;
    unsigned char* ws = p.ws;
    const bf16_t* Qg = (const bf16_t*)(ws + WS_Q) + ((size_t)bh * SEQ + qb * 256 + wid * 32 + l31) * QKH;
    const bf16_t* Kg = (const bf16_t*)(ws + WS_K) + (size_t)bh * TKP * QKH;
    const bf16_t* Vg = (const bf16_t*)(ws + WS_VT) + (size_t)bh * 64 * TKP;
    constexpr int KST = 208, VST = 144, KBUF = 64 * KST;
    bf16x8 qr[6];
#pragma unroll
    for (int ks = 0; ks < 6; ++ks) qr[ks] = *(const bf16x8*)(Qg + 16 * ks + 8 * hi);
    bool fast;
    { float gq = fabsf(p.in[8][lane]), gk = fabsf(p.in[9][lane]);
      if (lane < 32) { gq = fmaxf(gq, fabsf(p.in[8][64 + lane])); gk = fmaxf(gk, fabsf(p.in[9][64 + lane])); }
#pragma unroll
      for (int o = 1; o < 64; o <<= 1) { gq = fmaxf(gq, __shfl_xor(gq, o)); gk = fmaxf(gk, __shfl_xor(gk, o)); }
      fast = __builtin_amdgcn_readfirstlane((14.2f * gq * gk < 40.0f) ? 1 : 0) != 0; }
    const int kr0 = tid / 12, kc0 = tid % 12, i1 = tid + 512, kr1 = i1 / 12, kc1 = i1 % 12, vd = tid >> 3, vc = tid & 7;
    const bool two = tid < 256;
    const int pi = (l31 & 0x13) | ((l31 & 4) << 1) | ((l31 & 8) >> 1);
    constexpr int VOFF = 2 * KBUF, VBUF = 64 * VST;
#define QK_TILE(P0, P1, kb_) do { const float nm_ = -m_run; _Pragma("unroll") for (int r = 0; r < 16; ++r) { P0[r] = nm_; P1[r] = nm_; } \
        _Pragma("unroll") for (int ks = 0; ks < 6; ++ks) { \
            const bf16x8 a0_ = *(const LAS bf16x8*)((kb_) + pi * KST + (16 * ks + 8 * hi) * 2); \
            const bf16x8 a1_ = *(const LAS bf16x8*)((kb_) + (32 + pi) * KST + (16 * ks + 8 * hi) * 2); \
            P0 = MFMA32(a0_, qr[ks], P0); P1 = MFMA32(a1_, qr[ks], P1); } } while (0)
    float m_run = 0.f, l_run = 0.f;
    f32x16 o0, o1;
#pragma unroll
    for (int r = 0; r < 16; ++r) { o0[r] = 0.f; o1[r] = 0.f; }
    u32x4 sKa0 = (u32x4){0u, 0u, 0u, 0u}, sKb0 = sKa0, sVa0 = sKa0, sKa1 = sKa0, sKb1 = sKa0, sVa1 = sKa0;
    __syncthreads();
    { const u32x4 kA = *(const u32x4*)(Kg + kr0 * QKH + kc0 * 8); u32x4 kB = (u32x4){0u, 0u, 0u, 0u}; if (two) kB = *(const u32x4*)(Kg + kr1 * QKH + kc1 * 8);
      const u32x4 vA = *(const u32x4*)(Vg + vd * 64 + vc * 8);
      const bf16_t* k1 = Kg + (size_t)64 * QKH;
      sKa1 = *(const u32x4*)(k1 + kr0 * QKH + kc0 * 8); if (two) sKb1 = *(const u32x4*)(k1 + kr1 * QKH + kc1 * 8); sVa1 = *(const u32x4*)(Vg + (size_t)4096 + vd * 64 + vc * 8);
      *(LAS u32x4*)(lds + kr0 * KST + kc0 * 16) = kA; if (two) *(LAS u32x4*)(lds + kr1 * KST + kc1 * 16) = kB;
      *(LAS u32x4*)(lds + VOFF + vd * VST + vc * 16) = vA; }
    __syncthreads();
#define ATT_STEP(T_, FAST_, IKA, IKB, IVA, WKA, WKB, WVA) do { \
        const bool wr_ = ((T_) + 1) < NKT, iss_ = ((T_) + 2) < NKT; \
        if (iss_) { const bf16_t* kt = Kg + (size_t)((T_) + 2) * 64 * QKH; IKA = *(const u32x4*)(kt + kr0 * QKH + kc0 * 8); if (two) IKB = *(const u32x4*)(kt + kr1 * QKH + kc1 * 8); \
            IVA = *(const u32x4*)(Vg + (size_t)((T_) + 2) * 4096 + vd * 64 + vc * 8); } \
        LAS const unsigned char* kb_ = lds + ((T_) & 1) * KBUF; LAS const unsigned char* vb_ = lds + VOFF + ((T_) & 1) * VBUF; \
        f32x16 p0, p1; \
        QK_TILE(p0, p1, kb_); \
        if ((T_) == NKT - 1) { \
_Pragma("unroll") \
            for (int r = 8; r < 16; ++r) p0[r] = -INFINITY; \
_Pragma("unroll") \
            for (int r = 0; r < 16; ++r) p1[r] = -INFINITY; } \
        if (!(FAST_)) { \
            float mx = fmaxf(fmaxf(p0[0], p1[0]), fmaxf(p0[1], p1[1])); \
_Pragma("unroll") \
            for (int r = 2; r < 16; r += 2) mx = fmaxf(fmaxf(mx, fmaxf(p0[r], p1[r])), fmaxf(p0[r + 1], p1[r + 1])); \
            mx = fmaxf(mx, __shfl_xor(mx, 32)); \
            if (__any(mx > 8.0f)) { \
                const float dl = fmaxf(mx, 0.f); const float alpha = __builtin_amdgcn_exp2f(-dl); l_run *= alpha; m_run += dl; \
_Pragma("unroll") \
                for (int r = 0; r < 16; ++r) { o0[r] *= alpha; o1[r] *= alpha; p0[r] -= dl; p1[r] -= dl; } } } \
        float rs = 0.f; \
_Pragma("unroll") \
        for (int r = 0; r < 16; ++r) { p0[r] = __builtin_amdgcn_exp2f(p0[r]); p1[r] = __builtin_amdgcn_exp2f(p1[r]); rs += p0[r] + p1[r]; } \
        l_run += rs; \
        bf16x8 pb[2][2]; \
_Pragma("unroll") \
        for (int s = 0; s < 2; ++s) { u32x4 w0, w1; \
            w0.x = cvt_pk(p0[8 * s + 0], p0[8 * s + 1]); w0.y = cvt_pk(p0[8 * s + 2], p0[8 * s + 3]); w0.z = cvt_pk(p0[8 * s + 4], p0[8 * s + 5]); w0.w = cvt_pk(p0[8 * s + 6], p0[8 * s + 7]); \
            w1.x = cvt_pk(p1[8 * s + 0], p1[8 * s + 1]); w1.y = cvt_pk(p1[8 * s + 2], p1[8 * s + 3]); w1.z = cvt_pk(p1[8 * s + 4], p1[8 * s + 5]); w1.w = cvt_pk(p1[8 * s + 6], p1[8 * s + 7]); \
            pb[0][s] = __builtin_bit_cast(bf16x8, w0); pb[1][s] = __builtin_bit_cast(bf16x8, w1); } \
_Pragma("unroll") \
        for (int kb = 0; kb < 2; ++kb) \
_Pragma("unroll") \
            for (int s = 0; s < 2; ++s) { \
                const bf16x8 v0 = *(const LAS bf16x8*)(vb_ + l31 * VST + (32 * kb + 16 * s + 8 * hi) * 2); \
                const bf16x8 v1 = *(const LAS bf16x8*)(vb_ + (32 + l31) * VST + (32 * kb + 16 * s + 8 * hi) * 2); \
                o0 = MFMA32(v0, pb[kb][s], o0); o1 = MFMA32(v1, pb[kb][s], o1); } \
        if (wr_) { LAS unsigned char* nk_ = lds + (((T_) + 1) & 1) * KBUF; *(LAS u32x4*)(nk_ + kr0 * KST + kc0 * 16) = WKA; if (two) *(LAS u32x4*)(nk_ + kr1 * KST + kc1 * 16) = WKB; \
            LAS unsigned char* nv_ = lds + VOFF + (((T_) + 1) & 1) * VBUF; *(LAS u32x4*)(nv_ + vd * VST + vc * 16) = WVA; } \
        asm volatile("s_waitcnt lgkmcnt(0)\n\ts_barrier" ::: "memory"); \
    } while (0)
    if (fast) { int t = 0;
#pragma unroll 1
      for (; t + 1 < NKT; t += 2) { ATT_STEP(t, true, sKa0, sKb0, sVa0, sKa1, sKb1, sVa1); ATT_STEP(t + 1, true, sKa1, sKb1, sVa1, sKa0, sKb0, sVa0); }
      if (t < NKT) ATT_STEP(t, true, sKa0, sKb0, sVa0, sKa1, sKb1, sVa1); }
    else { int t = 0;
#pragma unroll 1
      for (; t + 1 < NKT; t += 2) { ATT_STEP(t, false, sKa0, sKb0, sVa0, sKa1, sKb1, sVa1); ATT_STEP(t + 1, false, sKa1, sKb1, sVa1, sKa0, sKb0, sVa0); }
      if (t < NKT) ATT_STEP(t, false, sKa0, sKb0, sVa0, sKa1, sKb1, sVa1); }
#undef ATT_STEP
#undef QK_TILE
    const float l = l_run + __shfl_xor(l_run, 32); const float inv = 1.0f / l;
    const int b = bh >> 3, h = bh & 7;
    const size_t rr = (size_t)b * SEQ + qb * 256 + wid * 32 + l31;
    LAS bf16_t* ost = (LAS bf16_t*)(lds + 45056 + wid * 4608);
    float q = 0.f;
#pragma unroll
    for (int gq = 0; gq < 4; ++gq) {
        const float a0 = o0[4 * gq] * inv, a1 = o0[4 * gq + 1] * inv, a2 = o0[4 * gq + 2] * inv, a3 = o0[4 * gq + 3] * inv;
        const float c0 = o1[4 * gq] * inv, c1 = o1[4 * gq + 1] * inv, c2 = o1[4 * gq + 2] * inv, c3 = o1[4 * gq + 3] * inv;
        q += (a0 * a0 + a1 * a1) + (a2 * a2 + a3 * a3) + (c0 * c0 + c1 * c1) + (c2 * c2 + c3 * c3);
        u32x2 w; w.x = cvt_pk(a0, a1); w.y = cvt_pk(a2, a3); *(LAS u32x2*)(ost + l31 * 72 + 8 * gq + 4 * hi) = w;
        w.x = cvt_pk(c0, c1); w.y = cvt_pk(c2, c3); *(LAS u32x2*)(ost + l31 * 72 + 32 + 8 * gq + 4 * hi) = w; }
    asm volatile("s_waitcnt lgkmcnt(0)" ::: "memory");
    { bf16_t* dstw = (bf16_t*)(ws + WS_MIX) + ((size_t)b * SEQ + qb * 256 + wid * 32) * DM + 64 * h;
#pragma unroll
      for (int j = 0; j < 4; ++j) { const int c = lane + 64 * j, row = c >> 3, c16 = c & 7; *(u32x4*)(dstw + (size_t)row * DM + 8 * c16) = *(const LAS u32x4*)(ost + row * 72 + 8 * c16); } }
    asm volatile("s_waitcnt lgkmcnt(0)" ::: "memory");
    q += __shfl_xor(q, 32);
    if (hi == 0) fadd_atomic((float*)(ws + WS_SS) + 2 * MT + rr, q);
}

#define XB_TMO      128
#define XB_XCNT(j)  (256  + 64 * (j))
#define XB_XSUB(j)  (1280 + 64 * (j))
#define XB_XGEN(j)  (2304 + 64 * (j))
#define XB_TOP      3328
#define XB_TOPGEN   3392
#define XCD_BAR_WORDS 3456
#define XB_SPIN_CAP (1u << 18)
__device__ __forceinline__ unsigned xb_ld(unsigned* p)              { return __hip_atomic_load(p, __ATOMIC_RELAXED, __HIP_MEMORY_SCOPE_AGENT); }
__device__ __forceinline__ unsigned xb_add(unsigned* p, unsigned v) { return __hip_atomic_fetch_add(p, v, __ATOMIC_RELAXED, __HIP_MEMORY_SCOPE_AGENT); }
__device__ __forceinline__ unsigned xb_xcc_id() { return (unsigned)__builtin_amdgcn_s_getreg((3 << 11) | 20) & 0xFu; }
#define XB_SPIN(cond, bar) do { unsigned _sp = 0; while (cond) { __builtin_amdgcn_s_sleep(1); \
    if ((++_sp & 255u) == 0u) { if (xb_ld(&(bar)[XB_TMO])) break; if (_sp > XB_SPIN_CAP) { atomicAdd(&(bar)[XB_TMO], 1u); break; } } } } while (0)
struct XcdBarrier { unsigned* bar; unsigned x; volatile LAS unsigned* st; };
__device__ __forceinline__ XcdBarrier xcd_barrier_post(unsigned* bar, volatile LAS unsigned* st) {
    XcdBarrier b; b.bar = bar; b.x = xb_xcc_id(); b.st = st;
    if (threadIdx.x == 0) (void)xb_add(&bar[XB_XCNT(b.x)], 1u);
    return b;
}
__device__ __forceinline__ void xcd_barrier_complete(unsigned* bar, unsigned x, unsigned& nloc, unsigned& nx) {
    const unsigned G = gridDim.x * gridDim.y * gridDim.z;
    unsigned sum, cnt, mine, sp = 0u;
    for (;;) {
        sum = 0u; cnt = 0u; mine = 0u;
#pragma unroll
        for (unsigned j = 0; j < 16; ++j) { const unsigned c = xb_ld(&bar[XB_XCNT(j)]); sum += c; cnt += (c > 0u) ? 1u : 0u; mine = (j == x) ? c : mine; }
        if (sum == G) break;
        __builtin_amdgcn_s_sleep(1);
        if ((++sp & 255u) == 0u) { if (xb_ld(&bar[XB_TMO])) break; if (sp > XB_SPIN_CAP) { atomicAdd(&bar[XB_TMO], 1u); break; } }
    }
    nloc = mine > 0u ? mine : 1u; nx = cnt > 0u ? cnt : 1u;
}
__device__ __forceinline__ void xcd_barrier(const XcdBarrier& b) {
    asm volatile("s_waitcnt vmcnt(0)" ::: "memory");
    __syncthreads();
    if (threadIdx.x == 0) {
        unsigned* bar = b.bar;
        __builtin_amdgcn_s_waitcnt(0);
        unsigned nloc = b.st[0], nx = b.st[1];
        if (nloc == 0u) { xcd_barrier_complete(bar, b.x, nloc, nx); b.st[0] = nloc; b.st[1] = nx; }
        const unsigned old = xb_add(&bar[XB_XSUB(b.x)], 1u);
        const unsigned gen = old / nloc;
        if (old + 1u == (gen + 1u) * nloc) {
            __builtin_amdgcn_fence(__ATOMIC_RELEASE, "agent");
            asm volatile("s_waitcnt vmcnt(0)" ::: "memory");
            const unsigned og = xb_add(&bar[XB_TOP], 1u);
            const unsigned tg = og / nx;
            if (og + 1u == (tg + 1u) * nx) xb_add(&bar[XB_TOPGEN], 1u);
            else XB_SPIN(xb_ld(&bar[XB_TOPGEN]) == tg, bar);
            __builtin_amdgcn_fence(__ATOMIC_ACQUIRE, "agent");
            xb_add(&bar[XB_XGEN(b.x)], 1u);
            asm volatile("s_waitcnt vmcnt(0)" ::: "memory");
        } else {
            XB_SPIN(xb_ld(&bar[XB_XGEN(b.x)]) == gen, bar);
            __builtin_amdgcn_fence(__ATOMIC_ACQUIRE, "agent");
            asm volatile("s_waitcnt vmcnt(0)" ::: "memory");
        }
    }
    __syncthreads();
}

__global__ void __launch_bounds__(512, 2) hymba_fwd(Params p) {
    extern __shared__ __attribute__((aligned(16))) unsigned char lds_raw[];
    LAS unsigned char* lds = (LAS unsigned char*)lds_raw;
    cg::grid_group grid = cg::this_grid();
    const int G = gridDim.x, bx = blockIdx.x;
    const int vcu = (G % 8 == 0) ? (bx % 8) * (G / 8) + bx / 8 : bx;
    unsigned char* ws = p.ws;
    float* ssf = (float*)(ws + WS_SS);
    const int lo = p.ph_lo, hi = p.ph_hi;
    volatile LAS unsigned* bst = (volatile LAS unsigned*)(lds + LDS_BYTES - 16);
    if (threadIdx.x < 4) bst[threadIdx.x] = 0u;
    __syncthreads();
    XcdBarrier xbar = xcd_barrier_post((unsigned*)(ws + WS_BAR) + p.li * XCD_BAR_WORDS, bst);
    if (lo == 12345) grid.sync();
#ifndef TEST_SUB
#define TEST_SUB -1
#endif
#ifndef TEST_PHASE
#define TEST_PHASE -1
#endif
#define IN(k) ((TEST_PHASE < 0 || TEST_PHASE == (k)) && lo <= (k) && (k) < hi)
#define SEAM(k) do { if (IN(k) && IN((k) + 1)) xcd_barrier(xbar); } while (0)
    if (IN(0)) { phase_prep(p, lds); } SEAM(0);
    if (IN(1)) { pg8::Gemm g{(const bf16_t*)(ws + WS_HB), (const bf16_t*)(ws + WS_WIN), MT, INP, 1024, 1024, 1024}; pg8::StaticOrder S; S.init(MT, INP, G, bx);
        pg8::EpiInProj E{(bf16_t*)(ws + WS_P), ssf + 2 * MT + 3 * MR, ssf, ssf + MT};
        pg8::gemm_phase<pg8::EpiInProj, pg8::StaticOrder, true>(lds, g, S, E);
        {
          const int nwg = (MT / 256) * (INP / 256), rounds = (nwg + G - 1) / G, first_idle = nwg - (rounds - 1) * G;
          const int n_idle = G - first_idle;
          if (n_idle <= 0) prep_transposes(p, lds, I_WIN, NIT, bx * 8 + (int)(threadIdx.x >> 6), G * 8);
          else if (bx >= first_idle) prep_transposes(p, lds, I_WIN, NIT, (bx - first_idle) * 8 + (int)(threadIdx.x >> 6), n_idle * 8); } } SEAM(1);
    if (IN(2)) { constexpr int NS = BATCH * 8 * 2, NHU = 8 * 32, NBLK = MT / 16;
        const int nun = (NS + NHU - vcu + G - 1) / G;
        for (int k = 0; k < nun; ++k) {
            const int kk = (((vcu >> 3) & 1) && nun == 2) ? 1 - k : k; const int u = vcu + kk * G;
            if (u < NS) { const int bg = u >> 1; if (u & 1) rnn_scan_unit<1>(p, lds, bg >> 3, bg & 7); else rnn_scan_unit<0>(p, lds, bg >> 3, bg & 7); }
            else { const int j = u - NS, hh = j & 7, r = j >> 3; qkv_head_unit(p, lds, hh, (r * NBLK) / 32, ((r + 1) * NBLK) / 32); } } } SEAM(2);
    if (IN(3)) { constexpr int NA = BATCH * NH * 8;
        const bool comb_first = ((vcu >> 3) & 1) == 0;
        if (comb_first) rnn_combine(p);
        for (int u = vcu; u < NA; u += G) attn_unit(p, lds, u >> 3, u & 7);
        if (!comb_first) rnn_combine(p); } SEAM(3);
    if (IN(4)) { pg8::Gemm g{(const bf16_t*)(ws + WS_MIX), (const bf16_t*)(ws + WS_WOUT), MR, 1024, 1024, 1024, 1024}; pg8::StaticOrder S; S.init(MR, 1024, G, bx);
        pg8::EpiOut E{p.in[0], (bf16_t*)(ws + WS_H), (bf16_t*)(ws + WS_HB), ssf + 2 * MT, ssf + 2 * MT + MR, ssf + 2 * MT + 2 * MR};
        pg8::gemm_phase<pg8::EpiOut, pg8::StaticOrder, true>(lds, g, S, E); } SEAM(4);
    if (IN(5)) { pg8::Gemm g{(const bf16_t*)(ws + WS_HB), (const bf16_t*)(ws + WS_WGU), MR, 2 * DFF, 1024, 1024, 1024}; pg8::StaticOrder S; S.init(MR, 2 * DFF, G, bx);
        pg8::EpiUp E{(bf16_t*)(ws + WS_P), ssf + 2 * MT + 2 * MR};
        pg8::gemm_phase<pg8::EpiUp, pg8::StaticOrder, true>(lds, g, S, E); } SEAM(5);
    if (IN(6)) { pg8::Gemm g{(const bf16_t*)(ws + WS_P), (const bf16_t*)(ws + WS_WDN), MR, 1024, DFF, DFF, DFF}; pg8::StaticOrder S; S.init(MR, 1024, G, bx);
        pg8::EpiDown E{p.out, (const bf16_t*)(ws + WS_HB), (const bf16_t*)(ws + WS_H)};
        pg8::gemm_phase<pg8::EpiDown, pg8::StaticOrder, true>(lds, g, S, E); }
#undef IN
#undef SEAM
}

#ifndef REPEAT_HI
#define REPEAT_HI -1
#endif
#ifndef N_LAUNCH_MODE
#define N_LAUNCH_MODE 1
#endif
extern "C" void kernel_launch(void* const* d_in, const int* in_sizes, int n_in, void* d_out, int out_size, void* d_ws, size_t ws_size, hipStream_t stream) {
    static int grid = 0;
    if (grid == 0) {
        if (n_in != 24 || out_size != MR * DM || ws_size < WS_END) { fprintf(stderr, "kernel_launch: unexpected problem (n_in %d, out %d, ws %zu)\n", n_in, out_size, ws_size); grid = -1; return; }
        int dev = 0, cus = 0, per_cu = 0;
        hipGetDevice(&dev); hipDeviceGetAttribute(&cus, hipDeviceAttributeMultiprocessorCount, dev);
        if (hipFuncSetAttribute((const void*)hymba_fwd, hipFuncAttributeMaxDynamicSharedMemorySize, LDS_BYTES) != hipSuccess) { fprintf(stderr, "kernel_launch: hipFuncSetAttribute failed\n"); grid = -1; return; }
        if (hipOccupancyMaxActiveBlocksPerMultiprocessor(&per_cu, (const void*)hymba_fwd, 512, LDS_BYTES) != hipSuccess || per_cu < 1) { fprintf(stderr, "kernel_launch: occupancy query gave %d\n", per_cu); per_cu = 1; }
        (void)hipGetLastError();
        grid = cus * per_cu;
    }
    if (grid < 0) return;
    Params p{};
    for (int i = 0; i < 24; ++i) p.in[i] = (const float*)d_in[i];
    p.out = (float*)d_out; p.ws = (unsigned char*)d_ws;
#if N_LAUNCH_MODE == 1
    void* args[] = {&p};
    (void)hipMemsetAsync((unsigned char*)d_ws + WS_BAR, 0, BAR_ZERO_BYTES, stream);
#if REPEAT_HI >= 0
    p.ph_lo = 0; p.ph_hi = REPEAT_HI + 1; p.li = 1;
    (void)hipLaunchCooperativeKernel((const void*)hymba_fwd, dim3(grid), dim3(512), args, LDS_BYTES, stream);
#endif
    p.ph_lo = 0; p.ph_hi = 7; p.li = 0;
    hipError_t e = hipLaunchCooperativeKernel((const void*)hymba_fwd, dim3(grid), dim3(512), args, LDS_BYTES, stream);
    if (e != hipSuccess) fprintf(stderr, "cooperative launch failed: %s (grid %d)\n", hipGetErrorString(e), grid);
#else
    for (int ph = 0; ph < 7; ++ph) { p.ph_lo = ph; p.ph_hi = ph + 1; p.li = 0; hipLaunchKernelGGL(hymba_fwd, dim3(grid), dim3(512), LDS_BYTES, stream, p); }
#endif
}
```

```cpp
#include <hip/hip_runtime.h>
#include <hip/hip_cooperative_groups.h>
#include <cstdio>
#include <cstdint>
namespace cg = cooperative_groups;

#define LAS __attribute__((address_space(3)))
typedef unsigned short bf16_t;
typedef short bf16x8 __attribute__((ext_vector_type(8)));
typedef float f32x4 __attribute__((ext_vector_type(4)));
typedef float f32x16 __attribute__((ext_vector_type(16)));
typedef unsigned u32x4 __attribute__((ext_vector_type(4)));
typedef unsigned u32x2 __attribute__((ext_vector_type(2)));

constexpr int BATCH = 16, SEQ = 2048, NMETA = 16, TT = SEQ + NMETA, DM = 1024;
constexpr int MT = BATCH * TT;
constexpr int MR = BATCH * SEQ;
constexpr int INC = 1696, INP = 1792;
constexpr int C_CKV = 384, C_KR = 640, C_XR = 672, C_GATE = 1184;
constexpr int NH = 8, QKH = 96, TKP = 2112, NKT = TKP / 64;
constexpr int DFF = 2816, NCH = 17;
constexpr float EPS = 1e-6f;
constexpr float QSCALE = 0.10206207261596577f * 1.4426950408889634f;

constexpr size_t MiB = 1u << 20;
constexpr size_t WS_SS = 0;
constexpr size_t WS_BAR = 1 * MiB;
constexpr int BAR_ZERO_BYTES = 65536;
constexpr size_t WS_WLRU = 4 * MiB;
constexpr size_t WS_WIN = 5 * MiB, WS_WUQ = 9 * MiB, WS_WUKV = 10 * MiB, WS_WOUT = 11 * MiB, WS_WGU = 13 * MiB, WS_WDN = 25 * MiB;
constexpr size_t WS_HB = 32 * MiB;
constexpr size_t WS_P = 100 * MiB;
constexpr size_t WS_Q = 213 * MiB;
constexpr size_t WS_K = 261 * MiB;
constexpr size_t WS_VT = 311 * MiB;
constexpr size_t WS_MIX = 344 * MiB;
constexpr size_t WS_H = 408 * MiB;
constexpr size_t WS_END = 473 * MiB;
constexpr int LDS_BYTES = 147456;

struct Params { const float* in[24]; float* out; unsigned char* ws; int ph_lo, ph_hi, li, pad; };

__device__ __forceinline__ unsigned cvt_pk(float lo, float hi) { unsigned r; asm("v_cvt_pk_bf16_f32 %0, %1, %2" : "=v"(r) : "v"(lo), "v"(hi)); return r; }
__device__ __forceinline__ float bf2f(unsigned short b) { return __uint_as_float(((unsigned)b) << 16); }
__device__ __forceinline__ float bflo(unsigned w) { return __uint_as_float(w << 16); }
__device__ __forceinline__ float bfhi(unsigned w) { return __uint_as_float(w & 0xffff0000u); }
__device__ __forceinline__ float wave_sum(float v) {
#pragma unroll
    for (int o = 1; o < 64; o <<= 1) v += __shfl_xor(v, o);
    return v;
}
__device__ __forceinline__ void fadd_atomic(float* p, float v) { __hip_atomic_fetch_add(p, v, __ATOMIC_RELAXED, __HIP_MEMORY_SCOPE_AGENT); }
__device__ __forceinline__ float frsq(float x) { return __builtin_amdgcn_rsqf(x); }
__device__ __forceinline__ float sigmoidf_(float x) { return 1.0f / (1.0f + __expf(-x)); }
__device__ __forceinline__ void sincos_rr(float x, float& s, float& c) {
    const float k = rintf(x * 0.15915494309189535f);
    float r = fmaf(-k, 6.2831854820251465f, x);
    r = fmaf(-k, -1.7484555314695172e-7f, r);
    const float rev = r * 0.15915494309189535f;
    s = __builtin_amdgcn_sinf(rev); c = __builtin_amdgcn_cosf(rev);
}

namespace pg8 {
#define PG8_LAS __attribute__((address_space(3)))
constexpr int BM = 256, BK = 64, HALF = 128, HTB = HALF * BK * 2, STAGE_BYTES = 8 * HTB, NXCD = 8, WGM = 8;
__host__ __device__ __forceinline__ int lds_byte(int r, int c) { const int st = (r >> 4) * 2 + (c >> 5), rr = r & 15, cc = c & 31, ob = rr * 64 + cc * 2; return st * 1024 + (ob ^ (((ob >> 9) & 1) << 5)); }
__host__ __device__ __forceinline__ void stage_rc(int b, int& R, int& C) { const int st = b / 1024, sb = b % 1024, swz = sb ^ (((sb >> 9) & 1) << 5); R = (st >> 1) * 16 + swz / 64; C = (st & 1) * 32 + (swz % 64) / 2; }
__host__ __device__ __forceinline__ int perm32(int rho) { const int n = rho >> 4, i = rho & 15; return 8 * (i >> 2) + 4 * n + (i & 3); }
struct Unit { int pm, pn; };
struct Gemm { const bf16_t* A; const bf16_t* Bt; int M, N, K, lda, ldb; };
struct StaticOrder {
    int nM, nN, nwg, G, c;
    __device__ void init(int M, int N, int G_, int c_) { nM = M / BM; nN = N / BM; nwg = nM * nN; G = G_; c = c_; }
    __device__ bool next(int i, Unit& u) const {
        const long L = (long)i * G + c; if (L >= nwg) return false;
        int wgid = (int)L; { const int q = nwg / NXCD, r = nwg % NXCD, xcd = wgid % NXCD, off = wgid / NXCD; wgid = (xcd < r ? xcd * (q + 1) : r * (q + 1) + (xcd - r) * q) + off; }
        const int nig = WGM * nN, gid = wgid / nig, fm = gid * WGM, gsz = (nM - fm) < WGM ? (nM - fm) : WGM;
        u.pm = fm + ((wgid % nig) % gsz); u.pn = (wgid % nig) / gsz; return true;
    }
};
template <class Epi, class Sched, bool ALIGN_EPI>
__device__ __forceinline__ void gemm_phase(PG8_LAS unsigned char* lds, const Gemm g, const Sched& S, const Epi& E) {
    const int tid = threadIdx.x, wid = __builtin_amdgcn_readfirstlane(tid >> 6), lane = tid & 63, wr = wid >> 2, wc = wid & 3, fr = lane & 15, fq = lane >> 4;
    const int K = g.K, nt = K / BK;
    unsigned voffA[2], voffB[2];
#pragma unroll
    for (int i = 0; i < 2; ++i) { int R, C; stage_rc(tid * 16 + i * 8192, R, C); const int Rb = Epi::PERM ? ((R & ~31) + perm32(R & 31)) : R;
        voffA[i] = (unsigned)(R * g.lda + C) * 2u; voffB[i] = (unsigned)(Rb * g.ldb + C) * 2u; }
    const size_t kstep = (size_t)(BK * 2);
    const size_t hsA = (size_t)HALF * g.lda * 2, hsB = (size_t)HALF * g.ldb * 2, tsA = 2 * hsA, tsB = 2 * hsB;
    const unsigned ldsw = (unsigned)wid * 1024u;
    const int aoff = lds_byte(wr * 64 + fr, fq * 8), boff = lds_byte(wc * 32 + fr, fq * 8);
#define PG8_SA(b, h) (((b) * 2 + (h)) * HTB)
#define PG8_SB(b, h) ((4 + (b) * 2 + (h)) * HTB)
#define PG8_STAGE(bufoff, gbase, voff) do { _Pragma("unroll") for (int _i = 0; _i < 2; ++_i) \
        __builtin_amdgcn_global_load_lds((const unsigned*)((const char*)(gbase) + (voff)[_i]), (PG8_LAS unsigned*)(lds + (bufoff) + ldsw + _i * 8192), 16, 0, 0); } while (0)
#define PG8_LDA(dst, b, h) do { _Pragma("unroll") for (int m = 0; m < 4; ++m) _Pragma("unroll") for (int k = 0; k < 2; ++k) dst[m][k] = *(const PG8_LAS bf16x8*)(lds + PG8_SA(b, h) + aoff + m * 2048 + k * 1024); } while (0)
#define PG8_LDB(dst, b, h) do { _Pragma("unroll") for (int n = 0; n < 2; ++n) _Pragma("unroll") for (int k = 0; k < 2; ++k) dst[n][k] = *(const PG8_LAS bf16x8*)(lds + PG8_SB(b, h) + boff + n * 2048 + k * 1024); } while (0)
#define PG8_MMA(ai, bj, At, Bt) do { __builtin_amdgcn_s_setprio(1); _Pragma("unroll") for (int m = 0; m < 4; ++m) _Pragma("unroll") for (int n = 0; n < 2; ++n) _Pragma("unroll") for (int k = 0; k < 2; ++k) \
        acc[ai][bj][m][n] = __builtin_amdgcn_mfma_f32_16x16x32_bf16(Bt[n][k], At[m][k], acc[ai][bj][m][n], 0, 0, 0); __builtin_amdgcn_s_setprio(0); } while (0)
#define PG8_WAIT_V(n) asm volatile("s_waitcnt vmcnt(" #n ")" ::: "memory")
#define PG8_WAIT_L(n) asm volatile("s_waitcnt lgkmcnt(" #n ")" ::: "memory")
#define PG8_BAR __builtin_amdgcn_s_barrier()
#define PG8_SCHED __builtin_amdgcn_sched_barrier(0)
    Unit cur, nxt; int ui = 0;
    if (!S.next(0, cur)) return;
    f32x4 acc[2][2][4][2];
#pragma unroll
    for (int a = 0; a < 2; ++a)
#pragma unroll
        for (int b = 0; b < 2; ++b)
#pragma unroll
            for (int m = 0; m < 4; ++m)
#pragma unroll
                for (int n = 0; n < 2; ++n) acc[a][b][m][n] = (f32x4){0.f, 0.f, 0.f, 0.f};
    bf16x8 At[4][2], B0[2][2], B1[2][2];
    const char* cA = (const char*)g.A + (size_t)cur.pm * tsA; const char* cB = (const char*)g.Bt + (size_t)cur.pn * tsB;
    PG8_STAGE(PG8_SB(0, 0), cB, voffB); PG8_STAGE(PG8_SB(0, 1), cB + hsB, voffB); PG8_STAGE(PG8_SA(0, 0), cA, voffA); PG8_STAGE(PG8_SA(0, 1), cA + hsA, voffA);
    if (wr == 1) PG8_BAR;
    PG8_WAIT_V(2); PG8_BAR;
    PG8_STAGE(PG8_SB(1, 0), cB + kstep, voffB); PG8_STAGE(PG8_SA(1, 0), cA + kstep, voffA); PG8_STAGE(PG8_SB(1, 1), cB + hsB + kstep, voffB);
    PG8_WAIT_V(6); PG8_BAR;
    for (;;) {
        const bool has_next = S.next(ui + 1, nxt);
        const char* nA = has_next ? (const char*)g.A + (size_t)nxt.pm * tsA : cA; const char* nB = has_next ? (const char*)g.Bt + (size_t)nxt.pn * tsB : cB;
        for (int t = 0; t < nt; t += 2) {
            const bool last = (t == nt - 2);
            const char* a1 = cA + (size_t)(t + 1) * kstep;
            const char* a2 = last ? nA : cA + (size_t)(t + 2) * kstep; const char* b2 = last ? nB : cB + (size_t)(t + 2) * kstep;
            const char* a3 = a2 + kstep; const char* b3 = b2 + kstep;
            if constexpr (Epi::MID_T >= 0) { if (t == Epi::MID_T) E.mid(acc, cur, wr, fr); }
            PG8_LDB(B0, 0, 0); PG8_LDB(B1, 0, 1); PG8_SCHED; PG8_LDA(At, 0, 0); PG8_STAGE(PG8_SA(1, 1), a1 + hsA, voffA);
            PG8_WAIT_V(8); PG8_WAIT_L(0); PG8_BAR; PG8_MMA(0, 0, At, B0); PG8_MMA(0, 1, At, B1); PG8_BAR; PG8_SCHED;
            PG8_LDA(At, 0, 1); PG8_STAGE(PG8_SB(0, 0), b2, voffB); PG8_STAGE(PG8_SB(0, 1), b2 + hsB, voffB); PG8_STAGE(PG8_SA(0, 0), a2, voffA);
            PG8_WAIT_V(8); PG8_WAIT_L(0); PG8_BAR; PG8_MMA(1, 0, At, B0); PG8_MMA(1, 1, At, B1); PG8_BAR; PG8_SCHED;
            PG8_LDB(B0, 1, 0); PG8_LDB(B1, 1, 1); PG8_SCHED; PG8_LDA(At, 1, 0); PG8_STAGE(PG8_SA(0, 1), a2 + hsA, voffA);
            PG8_WAIT_V(8); PG8_WAIT_L(0); PG8_BAR; PG8_MMA(0, 0, At, B0); PG8_MMA(0, 1, At, B1); PG8_BAR; PG8_SCHED;
            PG8_LDA(At, 1, 1); PG8_STAGE(PG8_SB(1, 0), b3, voffB); PG8_STAGE(PG8_SB(1, 1), b3 + hsB, voffB); PG8_STAGE(PG8_SA(1, 0), a3, voffA);
            PG8_WAIT_V(8); PG8_WAIT_L(0); PG8_BAR; PG8_MMA(1, 0, At, B0); PG8_MMA(1, 1, At, B1); PG8_BAR; PG8_SCHED;
        }
        if constexpr (ALIGN_EPI) { if (wr == 0) PG8_BAR; }
        E(acc, cur, wr, wc, fr, fq);
        if (!has_next) break;
#pragma unroll
        for (int a = 0; a < 2; ++a)
#pragma unroll
            for (int b = 0; b < 2; ++b)
#pragma unroll
                for (int m = 0; m < 4; ++m)
#pragma unroll
                    for (int n = 0; n < 2; ++n) acc[a][b][m][n] = (f32x4){0.f, 0.f, 0.f, 0.f};
        cur = nxt; cA = nA; cB = nB; ++ui;
        if constexpr (ALIGN_EPI) { if (wr == 1) PG8_BAR; }
    }
    PG8_WAIT_V(0);
    if constexpr (!ALIGN_EPI) { if (wr == 0) PG8_BAR; }
    PG8_BAR;
#undef PG8_SA
#undef PG8_SB
#undef PG8_STAGE
#undef PG8_LDA
#undef PG8_LDB
#undef PG8_MMA
#undef PG8_WAIT_V
#undef PG8_WAIT_L
#undef PG8_BAR
#undef PG8_SCHED
}

struct EpiInProj {
    static constexpr bool PERM = true; static constexpr int MID_T = 14;
    bf16_t* P; const float* rs1; float* ss_cq; float* ss_ckv; mutable float pre[8];
    __device__ __forceinline__ void mid(f32x4 (&)[2][2][4][2], const Unit& u, int wr, int fr) const {
        int row0 = u.pm * BM + wr * 64 + fr; asm volatile("" : "+v"(row0));
#pragma unroll
        for (int ai = 0; ai < 2; ++ai)
#pragma unroll
            for (int m = 0; m < 4; ++m) pre[ai * 4 + m] = rs1[row0 + ai * HALF + m * 16];
    }
    __device__ __forceinline__ void operator()(const f32x4 (&acc)[2][2][4][2], const Unit& u, int wr, int wc, int fr, int fq) const {
        int row0 = u.pm * BM + wr * 64 + fr; asm volatile("" : "+v"(row0));
#pragma unroll
        for (int ai = 0; ai < 2; ++ai)
#pragma unroll
            for (int m = 0; m < 4; ++m) { const int row = row0 + ai * HALF + m * 16; const float s = pre[ai * 4 + m];
#pragma unroll
                for (int bj = 0; bj < 2; ++bj) { const int hc = u.pn * 2 + bj; const int col = u.pn * BM + bj * HALF + wc * 32 + 8 * fq;
                    const f32x4 v0 = acc[ai][bj][m][0] * s, v1 = acc[ai][bj][m][1] * s;
                    u32x4 w; w.x = cvt_pk(v0[0], v0[1]); w.y = cvt_pk(v0[2], v0[3]); w.z = cvt_pk(v1[0], v1[1]); w.w = cvt_pk(v1[2], v1[3]);
                    *(u32x4*)(P + (size_t)row * INP + col) = w;
                    if (hc < 5) { float q = (v0[0] * v0[0] + v0[1] * v0[1]) + (v0[2] * v0[2] + v0[3] * v0[3]) + (v1[0] * v1[0] + v1[1] * v1[1]) + (v1[2] * v1[2] + v1[3] * v1[3]);
                        q += __shfl_xor(q, 16); q += __shfl_xor(q, 32);
                        if (fq == 0) fadd_atomic((hc < 3 ? ss_cq : ss_ckv) + row, q); } } }
    }
};
struct EpiOut {
    static constexpr bool PERM = true; static constexpr int MID_T = 8;
    const float* x; bf16_t* LO; bf16_t* H1B; const float* ss_a; const float* ss_b; float* ss2; mutable float pre[8];
    __device__ __forceinline__ void mid(f32x4 (&acc)[2][2][4][2], const Unit& u, int wr, int fr) const {
        int row0 = u.pm * BM + wr * 64 + fr; asm volatile("" : "+v"(row0));
#pragma unroll
        for (int ai = 0; ai < 2; ++ai)
#pragma unroll
            for (int m = 0; m < 4; ++m) { const int row = row0 + ai * HALF + m * 16;
                const float ra = frsq(ss_a[row] * (1.0f / 512.0f) + EPS), rb = frsq(ss_b[row] * (1.0f / 512.0f) + EPS); const float ratio = ra * __builtin_amdgcn_rcpf(rb); pre[ai * 4 + m] = rb;
#pragma unroll
                for (int bj = 0; bj < 2; ++bj)
#pragma unroll
                    for (int n = 0; n < 2; ++n) acc[ai][bj][m][n] *= ratio; }
    }
    __device__ __forceinline__ void operator()(const f32x4 (&acc)[2][2][4][2], const Unit& u, int wr, int wc, int fr, int fq) const {
        int row0 = u.pm * BM + wr * 64 + fr; asm volatile("" : "+v"(row0));
#pragma unroll
        for (int ai = 0; ai < 2; ++ai)
#pragma unroll
            for (int m = 0; m < 4; ++m) { const int row = row0 + ai * HALF + m * 16; const float rb = pre[ai * 4 + m]; float q = 0.f;
#pragma unroll
                for (int bj = 0; bj < 2; ++bj) { const size_t off = (size_t)row * DM + u.pn * BM + bj * HALF + wc * 32 + 8 * fq;
                    const f32x4 x0 = *(const f32x4*)(x + off), x1 = *(const f32x4*)(x + off + 4);
                    const f32x4 h0 = x0 + acc[ai][bj][m][0] * rb, h1 = x1 + acc[ai][bj][m][1] * rb;
                    u32x4 w; w.x = cvt_pk(h0[0], h0[1]); w.y = cvt_pk(h0[2], h0[3]); w.z = cvt_pk(h1[0], h1[1]); w.w = cvt_pk(h1[2], h1[3]); *(u32x4*)(H1B + off) = w;
                    u32x4 l; l.x = cvt_pk(h0[0] - bflo(w.x), h0[1] - bfhi(w.x)); l.y = cvt_pk(h0[2] - bflo(w.y), h0[3] - bfhi(w.y)); l.z = cvt_pk(h1[0] - bflo(w.z), h1[1] - bfhi(w.z)); l.w = cvt_pk(h1[2] - bflo(w.w), h1[3] - bfhi(w.w));
                    *(u32x4*)(LO + off) = l;
                    q += (h0[0] * h0[0] + h0[1] * h0[1]) + (h0[2] * h0[2] + h0[3] * h0[3]) + (h1[0] * h1[0] + h1[1] * h1[1]) + (h1[2] * h1[2] + h1[3] * h1[3]); }
                q += __shfl_xor(q, 16); q += __shfl_xor(q, 32);
                if (fq == 0) fadd_atomic(ss2 + row, q);
                asm volatile("" ::: "memory"); }
    }
};
struct EpiUp {
    static constexpr bool PERM = true; static constexpr int MID_T = 14;
    bf16_t* ACT; const float* ss2; mutable float pre[8];
    __device__ __forceinline__ void mid(f32x4 (&)[2][2][4][2], const Unit& u, int wr, int fr) const {
        int row0 = u.pm * BM + wr * 64 + fr; asm volatile("" : "+v"(row0));
#pragma unroll
        for (int ai = 0; ai < 2; ++ai)
#pragma unroll
            for (int m = 0; m < 4; ++m) pre[ai * 4 + m] = ss2[row0 + ai * HALF + m * 16];
    }
    __device__ __forceinline__ void operator()(const f32x4 (&acc)[2][2][4][2], const Unit& u, int wr, int wc, int fr, int fq) const {
        int row0 = u.pm * BM + wr * 64 + fr; asm volatile("" : "+v"(row0)); const int col = u.pn * HALF + wc * 32 + 8 * fq;
#pragma unroll
        for (int ai = 0; ai < 2; ++ai)
#pragma unroll
            for (int m = 0; m < 4; ++m) { const int row = row0 + ai * HALF + m * 16; const float s = frsq(pre[ai * 4 + m] * (1.0f / 1024.0f) + EPS);
                const float c = -1.4426950408889634f * s, s2 = s * s;
                f32x4 r[2];
#pragma unroll
                for (int n = 0; n < 2; ++n) { const f32x4 g = acc[ai][0][m][n], uu = acc[ai][1][m][n];
                    f32x4 e = g * c;
#pragma unroll
                    for (int i = 0; i < 4; ++i) e[i] = __builtin_amdgcn_exp2f(e[i]);
                    f32x4 d = e + 1.0f;
#pragma unroll
                    for (int i = 0; i < 4; ++i) d[i] = __builtin_amdgcn_rcpf(d[i]);
                    r[n] = (g * uu) * (d * s2); }
                u32x4 w; w.x = cvt_pk(r[0][0], r[0][1]); w.y = cvt_pk(r[0][2], r[0][3]); w.z = cvt_pk(r[1][0], r[1][1]); w.w = cvt_pk(r[1][2], r[1][3]);
                *(u32x4*)(ACT + (size_t)row * DFF + col) = w; }
    }
};
struct EpiDown {
    static constexpr bool PERM = true; static constexpr int MID_T = -1;
    float* out; const bf16_t* H1B; const bf16_t* LO;
    __device__ __forceinline__ void mid(f32x4 (&)[2][2][4][2], const Unit&, int, int) const {}
    __device__ __forceinline__ void operator()(const f32x4 (&acc)[2][2][4][2], const Unit& u, int wr, int wc, int fr, int fq) const {
        int row0 = u.pm * BM + wr * 64 + fr; asm volatile("" : "+v"(row0));
#pragma unroll
        for (int ai = 0; ai < 2; ++ai)
#pragma unroll
            for (int m = 0; m < 4; ++m) { const int row = row0 + ai * HALF + m * 16;
#pragma unroll
                for (int bj = 0; bj < 2; ++bj) { const size_t off = (size_t)row * DM + u.pn * BM + bj * HALF + wc * 32 + 8 * fq;
                    const u32x4 hw = *(const u32x4*)(H1B + off), lw = *(const u32x4*)(LO + off);
                    f32x4 o0, o1;
                    o0[0] = (bflo(hw.x) + bflo(lw.x)) + acc[ai][bj][m][0][0]; o0[1] = (bfhi(hw.x) + bfhi(lw.x)) + acc[ai][bj][m][0][1];
                    o0[2] = (bflo(hw.y) + bflo(lw.y)) + acc[ai][bj][m][0][2]; o0[3] = (bfhi(hw.y) + bfhi(lw.y)) + acc[ai][bj][m][0][3];
                    o1[0] = (bflo(hw.z) + bflo(lw.z)) + acc[ai][bj][m][1][0]; o1[1] = (bfhi(hw.z) + bfhi(lw.z)) + acc[ai][bj][m][1][1];
                    o1[2] = (bflo(hw.w) + bflo(lw.w)) + acc[ai][bj][m][1][2]; o1[3] = (bfhi(hw.w) + bfhi(lw.w)) + acc[ai][bj][m][1][3];
                    *(f32x4*)(out + off) = o0; *(f32x4*)(out + off + 4) = o1; } }
    }
};
}

__device__ __forceinline__ void transpose_item(const float* W, int N, const float* gain, bf16_t* WT, int ldt, int dst_row0, int k0, int n0, LAS float* scr, int lane) {
    { const int kq = lane >> 3, nq = lane & 7;
      f32x4 v[8]; float gv[8];
#pragma unroll
      for (int i = 0; i < 8; ++i) { const int kk = 8 * i + kq; gv[i] = gain ? gain[k0 + kk] : 1.0f; v[i] = *(const f32x4*)(W + (size_t)(k0 + kk) * N + n0 + 4 * nq); }
#pragma unroll
      for (int i = 0; i < 8; ++i) { const int kk = 8 * i + kq; LAS float* d = scr + kk * 33 + 4 * nq; d[0] = v[i][0] * gv[i]; d[1] = v[i][1] * gv[i]; d[2] = v[i][2] * gv[i]; d[3] = v[i][3] * gv[i]; } }
    asm volatile("s_waitcnt lgkmcnt(0)" ::: "memory");
    const int c = lane & 7;
#pragma unroll
    for (int j = 0; j < 4; ++j) { const int n = (lane >> 3) + 8 * j; const LAS float* s = scr + (8 * c) * 33 + n;
        u32x4 o; o.x = cvt_pk(s[0 * 33], s[1 * 33]); o.y = cvt_pk(s[2 * 33], s[3 * 33]); o.z = cvt_pk(s[4 * 33], s[5 * 33]); o.w = cvt_pk(s[6 * 33], s[7 * 33]);
        *(u32x4*)(WT + (size_t)(dst_row0 + n) * ldt + k0 + 8 * c) = o; }
    asm volatile("s_waitcnt lgkmcnt(0)" ::: "memory");
}
constexpr int I_WIN = 16 * 53, I_UQ = 6 * 24, I_UKV = 4 * 32, I_OUT = 16 * 32, I_G = 16 * 88, I_DN = 44 * 32;
constexpr int NIT = I_WIN + I_UQ + I_UKV + I_OUT + 2 * I_G + I_DN;
__device__ __forceinline__ void prep_transposes(const Params& p, LAS unsigned char* lds, int lo, int hi, int widx, int wcnt) {
    const int lane = threadIdx.x & 63, wave = threadIdx.x >> 6;
    LAS float* scr = (LAS float*)(lds + wave * 16384);
    unsigned char* ws = p.ws;
    for (int it = lo + widx; it < hi; it += wcnt) {
        int r = it;
        if (r < I_WIN) { const int kb = r / 53, nb = r % 53; transpose_item(p.in[3], INC, p.in[2], (bf16_t*)(ws + WS_WIN), 1024, 32 * nb, 64 * kb, 32 * nb, scr, lane); continue; } r -= I_WIN;
        if (r < I_UQ) { const int kb = r / 24, nb = r % 24; transpose_item(p.in[5], 768, p.in[4], (bf16_t*)(ws + WS_WUQ), 384, 32 * nb, 64 * kb, 32 * nb, scr, lane); continue; } r -= I_UQ;
        if (r < I_UKV) { const int kb = r / 32, nb = r % 32; transpose_item(p.in[7], 1024, p.in[6], (bf16_t*)(ws + WS_WUKV), 256, 32 * nb, 64 * kb, 32 * nb, scr, lane); continue; } r -= I_UKV;
        if (r < I_OUT) { const int kb = r / 32, nb = r % 32; const float* gn = (kb < 8) ? p.in[17] : (p.in[18] - 512); transpose_item(p.in[19], 1024, gn, (bf16_t*)(ws + WS_WOUT), 1024, 32 * nb, 64 * kb, 32 * nb, scr, lane); continue; } r -= I_OUT;
        if (r < 2 * I_G) { const int up = r >= I_G; if (up) r -= I_G; const int kb = r / 88, nb = r % 88; const int n0 = 32 * nb; const int drow = 256 * (n0 >> 7) + (n0 & 127) + (up ? 128 : 0);
            transpose_item(up ? p.in[22] : p.in[21], DFF, p.in[20], (bf16_t*)(ws + WS_WGU), 1024, drow, 64 * kb, n0, scr, lane); continue; } r -= 2 * I_G;
        { const int kb = r / 32, nb = r % 32; transpose_item(p.in[23], 1024, nullptr, (bf16_t*)(ws + WS_WDN), DFF, 32 * nb, 64 * kb, 32 * nb, scr, lane); }
    }
}
__device__ __forceinline__ void phase_prep(const Params& p, LAS unsigned char* lds) {
    const int tid = threadIdx.x, lane = tid & 63, wave = tid >> 6, G = gridDim.x;
    const int gw = blockIdx.x * 8 + wave, NGW = G * 8;
    unsigned char* ws = p.ws;
    prep_transposes(p, lds, 0, I_WIN, gw, NGW);
    { bf16_t* HB = (bf16_t*)(ws + WS_HB); float* rs1 = (float*)(ws + WS_SS) + (2 * MT + 3 * MR);
      for (int row = gw; row < MT; row += 2 * NGW) {
          const int rowB = row + NGW; const bool hasB = rowB < MT; const int rB = hasB ? rowB : row;
          const int b = row / TT, t = row % TT, b2 = rB / TT, t2 = rB % TT;
          const float* src = (t < NMETA) ? (p.in[1] + (size_t)t * DM) : (p.in[0] + ((size_t)b * SEQ + (t - NMETA)) * DM);
          const float* src2 = (t2 < NMETA) ? (p.in[1] + (size_t)t2 * DM) : (p.in[0] + ((size_t)b2 * SEQ + (t2 - NMETA)) * DM);
          f32x4 v[4], w[4]; float s = 0.f, s2 = 0.f;
#pragma unroll
          for (int j = 0; j < 4; ++j) { v[j] = __builtin_nontemporal_load((const f32x4*)src + 64 * j + lane); w[j] = __builtin_nontemporal_load((const f32x4*)src2 + 64 * j + lane); }
#pragma unroll
          for (int j = 0; j < 4; ++j) { s += (v[j][0] * v[j][0] + v[j][1] * v[j][1]) + (v[j][2] * v[j][2] + v[j][3] * v[j][3]); s2 += (w[j][0] * w[j][0] + w[j][1] * w[j][1]) + (w[j][2] * w[j][2] + w[j][3] * w[j][3]); }
          s = wave_sum(s); s2 = wave_sum(s2);
          if (lane == 0) { rs1[row] = frsq(s * (1.0f / 1024.0f) + EPS); if (hasB) rs1[rowB] = frsq(s2 * (1.0f / 1024.0f) + EPS); }
          u32x2* o8 = (u32x2*)(HB + (size_t)row * DM) + lane; u32x2* o8b = (u32x2*)(HB + (size_t)rB * DM) + lane;
#pragma unroll
          for (int j = 0; j < 4; ++j) { u32x2 x; x.x = cvt_pk(v[j][0], v[j][1]); x.y = cvt_pk(v[j][2], v[j][3]); o8[64 * j] = x; }
          if (hasB) {
#pragma unroll
              for (int j = 0; j < 4; ++j) { u32x2 x; x.x = cvt_pk(w[j][0], w[j][1]); x.y = cvt_pk(w[j][2], w[j][3]); o8b[64 * j] = x; } } } }
    const int gt = blockIdx.x * 512 + tid, NGT = G * 512;
    { float* ss = (float*)(ws + WS_SS); for (int i = gt; i < 2 * MT + 3 * MR; i += NGT) ss[i] = 0.f; }
    { u32x4* z = (u32x4*)((bf16_t*)(ws + WS_WIN) + (size_t)INC * 1024); for (int i = gt; i < (INP - INC) * 1024 / 8; i += NGT) z[i] = (u32x4){0u, 0u, 0u, 0u}; }
    { bf16_t* wl = (bf16_t*)(ws + WS_WLRU);
      for (int i = gt; i < 2 * 2 * 8 * 64 * 64; i += NGT) { const int ii = i & 63, j = (i >> 6) & 63, g = (i >> 12) & 7, which = (i >> 15) & 1, dir = (i >> 16) & 1;
          const float* src = which ? p.in[14] : p.in[12]; const float v = -1.4426950408889634f * src[((size_t)(dir * 8 + g) * 64 + ii) * 64 + j]; wl[i] = (bf16_t)(cvt_pk(v, 0.f) & 0xffffu); } }
    { bf16_t* Kb = (bf16_t*)(ws + WS_K);
      for (int i = gt; i < 128 * 576; i += NGT) { const int bh = i / 576, c = i % 576; *((u32x4*)(Kb + ((size_t)bh * TKP + TT) * QKH) + c) = (u32x4){0u, 0u, 0u, 0u}; } }
    { bf16_t* Vt = (bf16_t*)(ws + WS_VT);
      for (int i = gt; i < 128 * 64 * 6; i += NGT) { const int rowi = i / 6, c = i % 6, bh = rowi >> 6, d = rowi & 63; *((u32x4*)(Vt + ((size_t)bh * NKT + (NKT - 1)) * 4096 + d * 64 + 16) + c) = (u32x4){0u, 0u, 0u, 0u}; } }
}

#ifndef QD
#define QD 3
#endif
#define MFMA16(a, b, c) __builtin_amdgcn_mfma_f32_16x16x32_bf16((a), (b), (c), 0, 0, 0)
#define MFMA32(a, b, c) __builtin_amdgcn_mfma_f32_32x32x16_bf16((a), (b), (c), 0, 0, 0)

template <int N> __device__ __forceinline__ void wait_vm() { asm volatile("s_waitcnt vmcnt(%0)" :: "n"(N) : "memory"); }
template <int NM, int NF, int KS, int D, int LDW, int AST>
__device__ __forceinline__ void stream_gemm(const bf16_t* Wu  , unsigned voff  , const LAS bf16_t* a_lds, f32x4 (&acc)[NM][NF]) {
    static_assert(KS % D == 0, "K steps must be a multiple of the ring depth");
    bf16x8 st[D][NF];
    asm volatile("s_waitcnt vmcnt(0)" ::: "memory");
#pragma unroll
    for (int j = 0; j < D; ++j)
#pragma unroll
        for (int n = 0; n < NF; ++n) { const bf16_t* sb = Wu + (size_t)n * 16 * LDW + 32 * j; asm volatile("global_load_dwordx4 %0, %1, %2" : "=&v"(st[j][n]) : "v"(voff), "s"(sb) : "memory"); }
#pragma unroll 1
    for (int ks0 = 0; ks0 < KS; ks0 += D) {
#pragma unroll
        for (int j = 0; j < D; ++j) {
            const int ks = ks0 + j;
            wait_vm<(D - 1) * NF>();
#pragma unroll
            for (int n = 0; n < NF; ++n) asm volatile("" : "+v"(st[j][n]));
            bf16x8 af[NM];
#pragma unroll
            for (int m = 0; m < NM; ++m) af[m] = *(const LAS bf16x8*)(a_lds + (16 * m) * AST + 32 * ks);
#pragma unroll
            for (int m = 0; m < NM; ++m)
#pragma unroll
                for (int n = 0; n < NF; ++n) acc[m][n] = MFMA16(st[j][n], af[m], acc[m][n]);
            const int ksn = (ks + D < KS) ? ks + D : KS - 1;
#pragma unroll
            for (int n = 0; n < NF; ++n) { const bf16_t* sb = Wu + (size_t)n * 16 * LDW + 32 * ksn; asm volatile("global_load_dwordx4 %0, %1, %2" : "=&v"(st[j][n]) : "v"(voff), "s"(sb) : "memory"); }
        }
    }
    asm volatile("s_waitcnt vmcnt(0)" ::: "memory");
#pragma unroll
    for (int j = 0; j < D; ++j)
#pragma unroll
        for (int n = 0; n < NF; ++n) asm volatile("" : "+v"(st[j][n]));
}
template <int NM>
__device__ __forceinline__ void qkv_unit(const Params& p, LAS unsigned char* lds, int r0) {
    int tid_ = threadIdx.x; asm volatile("" : "+v"(tid_));
    const int tid = tid_, lane = tid & 63, h = tid >> 6, fr = lane & 15, fq = lane >> 4;
    const int hs = __builtin_amdgcn_readfirstlane(h);
    unsigned char* ws = p.ws;
    const bf16_t* P = (const bf16_t*)(ws + WS_P);
    const float* ss_cq = (const float*)(ws + WS_SS); const float* ss_ckv = ss_cq + MT;
    constexpr int CQS = 392, CKS = 264;
    LAS bf16_t* cq = (LAS bf16_t*)lds; LAS bf16_t* ckv = (LAS bf16_t*)(lds + 64 * CQS * 2);
    LAS bf16_t* stg = (LAS bf16_t*)(lds + 83968 + h * 3328);
    __syncthreads();
    for (int idx = tid; idx < 16 * NM * 48; idx += 512) { const int r = idx / 48, c = idx % 48; *(LAS u32x4*)(cq + r * CQS + c * 8) = *(const u32x4*)(P + (size_t)(r0 + r) * INP + c * 8); }
    for (int idx = tid; idx < 16 * NM * 32; idx += 512) { const int r = idx / 32, c = idx % 32; *(LAS u32x4*)(ckv + r * CKS + c * 8) = *(const u32x4*)(P + (size_t)(r0 + r) * INP + C_CKV + c * 8); }
    __syncthreads();
    {
        const bf16_t* W = (const bf16_t*)(ws + WS_WUQ) + (size_t)(96 * hs) * 384; const unsigned wv = (unsigned)(fr * 384 + 8 * fq) * 2u;
        f32x4 acc[NM][6];
#pragma unroll
        for (int m = 0; m < NM; ++m)
#pragma unroll
            for (int n = 0; n < 6; ++n) acc[m][n] = (f32x4){0.f, 0.f, 0.f, 0.f};
        stream_gemm<NM, 6, 12, 3, 384, CQS>(W, wv, cq + fr * CQS + 8 * fq, acc);
        const float* qg = p.in[8];
        bf16_t* Q = (bf16_t*)(ws + WS_Q);
        float ssv[NM]; f32x4 gvv[6];
#pragma unroll
        for (int m = 0; m < NM; ++m) ssv[m] = ss_cq[r0 + 16 * m + fr];
#pragma unroll
        for (int n = 0; n < 6; ++n) gvv[n] = *(const f32x4*)(qg + 16 * n + 4 * fq);
        float frq[4];
#pragma unroll
        for (int i = 0; i < 4; ++i) frq[i] = exp2f(-(float)(4 * fq + i) * (13.287712379549449f / 16.0f));
#pragma unroll 1
        for (int mi = 0; mi < NM; ++mi) {
            const int row = r0 + 16 * mi + fr, t = row % TT;
            const float sc = frsq(ssv[0] * (1.0f / 384.0f) + EPS);
            float ssq = 0.f;
#pragma unroll
            for (int n = 0; n < 6; ++n) { acc[0][n] *= sc; ssq += (acc[0][n][0] * acc[0][n][0] + acc[0][n][1] * acc[0][n][1]) + (acc[0][n][2] * acc[0][n][2] + acc[0][n][3] * acc[0][n][3]); }
            ssq += __shfl_xor(ssq, 16); ssq += __shfl_xor(ssq, 32);
            const float rq = frsq(ssq * (1.0f / 96.0f) + EPS);
#pragma unroll
            for (int n = 0; n < 6; ++n) acc[0][n] = acc[0][n] * rq * gvv[n];
#pragma unroll
            for (int i = 0; i < 4; ++i) { float sn, cs; sincos_rr((float)t * frq[i], sn, cs);
                const float x1 = acc[0][4][i], x2 = acc[0][5][i]; acc[0][4][i] = x1 * cs - x2 * sn; acc[0][5][i] = x1 * sn + x2 * cs; }
#pragma unroll
            for (int n = 0; n < 6; ++n) { u32x2 w; w.x = cvt_pk(acc[0][n][0] * QSCALE, acc[0][n][1] * QSCALE); w.y = cvt_pk(acc[0][n][2] * QSCALE, acc[0][n][3] * QSCALE); *(LAS u32x2*)(stg + fr * 104 + 16 * n + 4 * fq) = w; }
            asm volatile("s_waitcnt lgkmcnt(0)" ::: "memory");
#pragma unroll
            for (int j = 0; j < 3; ++j) { const int c = lane + 64 * j, rw = c / 12, cc = c % 12; const int row2 = r0 + 16 * mi + rw, b2 = row2 / TT, t2 = row2 % TT;
                const u32x4 v = *(const LAS u32x4*)(stg + rw * 104 + 8 * cc);
                if (t2 >= NMETA) *(u32x4*)(Q + (((size_t)(b2 * NH + h)) * SEQ + (t2 - NMETA)) * QKH + 8 * cc) = v; }
            asm volatile("s_waitcnt lgkmcnt(0)" ::: "memory");
            if constexpr (NM == 4) {
#pragma unroll
            for (int n = 0; n < 6; ++n) { acc[0][n] = acc[1][n]; acc[1][n] = acc[2][n]; acc[2][n] = acc[3][n]; }
            ssv[0] = ssv[1]; ssv[1] = ssv[2]; ssv[2] = ssv[3]; }
        }
    }
    {
        const bf16_t* W = (const bf16_t*)(ws + WS_WUKV) + (size_t)(128 * hs) * 256; const unsigned wv = (unsigned)(fr * 256 + 8 * fq) * 2u;
        f32x4 acc[NM][4];
#pragma unroll
        for (int m = 0; m < NM; ++m)
#pragma unroll
            for (int n = 0; n < 4; ++n) acc[m][n] = (f32x4){0.f, 0.f, 0.f, 0.f};
        stream_gemm<NM, 4, 8, 4, 256, CKS>(W, wv, ckv + fr * CKS + 8 * fq, acc);
        const float* kg = p.in[9];
        bf16_t* Kb = (bf16_t*)(ws + WS_K);
        float ssv[NM]; u32x2 k1v[NM], k2v[NM]; f32x4 gvv[6];
#pragma unroll
        for (int m = 0; m < NM; ++m) { const int row = r0 + 16 * m + fr; ssv[m] = ss_ckv[row]; k1v[m] = *(const u32x2*)(P + (size_t)row * INP + C_KR + 4 * fq); k2v[m] = *(const u32x2*)(P + (size_t)row * INP + C_KR + 16 + 4 * fq); }
#pragma unroll
        for (int n = 0; n < 6; ++n) gvv[n] = *(const f32x4*)(kg + 16 * n + 4 * fq);
        float frq[4];
#pragma unroll
        for (int i = 0; i < 4; ++i) frq[i] = exp2f(-(float)(4 * fq + i) * (13.287712379549449f / 16.0f));
#pragma unroll
        for (int mi = 0; mi < NM; ++mi) {
            const int row = r0 + 16 * mi + fr, t = row % TT;
            const float sc = frsq(ssv[mi] * (1.0f / 256.0f) + EPS);
            const u32x2 k1 = k1v[mi], k2 = k2v[mi];
            f32x4 kr1 = (f32x4){bflo(k1.x), bfhi(k1.x), bflo(k1.y), bfhi(k1.y)}, kr2 = (f32x4){bflo(k2.x), bfhi(k2.x), bflo(k2.y), bfhi(k2.y)};
            float ssq = (kr1[0] * kr1[0] + kr1[1] * kr1[1]) + (kr1[2] * kr1[2] + kr1[3] * kr1[3]) + (kr2[0] * kr2[0] + kr2[1] * kr2[1]) + (kr2[2] * kr2[2] + kr2[3] * kr2[3]);
#pragma unroll
            for (int n = 0; n < 4; ++n) { acc[mi][n] *= sc; ssq += (acc[mi][n][0] * acc[mi][n][0] + acc[mi][n][1] * acc[mi][n][1]) + (acc[mi][n][2] * acc[mi][n][2] + acc[mi][n][3] * acc[mi][n][3]); }
            ssq += __shfl_xor(ssq, 16); ssq += __shfl_xor(ssq, 32);
            const float rk = frsq(ssq * (1.0f / 96.0f) + EPS);
            LAS bf16_t* dstk = stg + fr * 104 + 4 * fq;
#pragma unroll
            for (int n = 0; n < 4; ++n) { const f32x4 v = acc[mi][n] * rk * gvv[n]; u32x2 w; w.x = cvt_pk(v[0], v[1]); w.y = cvt_pk(v[2], v[3]); *(LAS u32x2*)(dstk + 16 * n) = w; }
            { kr1 = kr1 * rk * gvv[4]; kr2 = kr2 * rk * gvv[5];
              f32x4 o1, o2;
#pragma unroll
              for (int i = 0; i < 4; ++i) { float sn, cs; sincos_rr((float)t * frq[i], sn, cs);
                  o1[i] = kr1[i] * cs - kr2[i] * sn; o2[i] = kr1[i] * sn + kr2[i] * cs; }
              u32x2 w; w.x = cvt_pk(o1[0], o1[1]); w.y = cvt_pk(o1[2], o1[3]); *(LAS u32x2*)(dstk + 64) = w; w.x = cvt_pk(o2[0], o2[1]); w.y = cvt_pk(o2[2], o2[3]); *(LAS u32x2*)(dstk + 80) = w; }
            asm volatile("s_waitcnt lgkmcnt(0)" ::: "memory");
#pragma unroll
            for (int j = 0; j < 3; ++j) { const int c = lane + 64 * j, rw = c / 12, cc = c % 12; const int row2 = r0 + 16 * mi + rw, b2 = row2 / TT, t2 = row2 % TT;
                const u32x4 v = *(const LAS u32x4*)(stg + rw * 104 + 8 * cc);
                *(u32x4*)(Kb + (((size_t)(b2 * NH + h)) * TKP + t2) * QKH + 8 * cc) = v; }
            asm volatile("s_waitcnt lgkmcnt(0)" ::: "memory"); __builtin_amdgcn_sched_barrier(0);
        }
    }
    {
        const bf16_t* W = (const bf16_t*)(ws + WS_WUKV) + (size_t)(128 * hs + 64) * 256; const unsigned wv = (unsigned)(fr * 256 + 8 * fq) * 2u;
        f32x4 acc[NM][4];
#pragma unroll
        for (int m = 0; m < NM; ++m)
#pragma unroll
            for (int n = 0; n < 4; ++n) acc[m][n] = (f32x4){0.f, 0.f, 0.f, 0.f};
        stream_gemm<NM, 4, 8, 4, 256, CKS>(W, wv, ckv + fr * CKS + 8 * fq, acc);
        bf16_t* Vt = (bf16_t*)(ws + WS_VT);
        float ssv[NM];
#pragma unroll
        for (int m = 0; m < NM; ++m) ssv[m] = ss_ckv[r0 + 16 * m + fr];
#pragma unroll
        for (int mi = 0; mi < NM; ++mi) {
            const float sc = frsq(ssv[mi] * (1.0f / 256.0f) + EPS);
#pragma unroll
            for (int n = 0; n < 4; ++n)
#pragma unroll
                for (int i = 0; i < 4; ++i) { const int d = 16 * n + 4 * fq + i; stg[d * 16 + fr] = (bf16_t)(cvt_pk(acc[mi][n][i] * sc, 0.f) & 0xffffu); }
            asm volatile("s_waitcnt lgkmcnt(0)" ::: "memory");
            { const int row2 = r0 + 16 * mi, b2 = row2 / TT, t2 = row2 % TT;
              bf16_t* dstv = Vt + (((size_t)(b2 * NH + h)) * NKT + (t2 >> 6)) * 4096 + (t2 & 63);
#pragma unroll
              for (int j = 0; j < 2; ++j) { const int c = lane + 64 * j, d = c >> 1, hf = c & 1; *(u32x4*)(dstv + d * 64 + 8 * hf) = *(const LAS u32x4*)(stg + d * 16 + 8 * hf); } }
            asm volatile("s_waitcnt lgkmcnt(0)" ::: "memory"); __builtin_amdgcn_sched_barrier(0);
        }
    }
}

__device__ __forceinline__ void qkv_head_unit(const Params& p, LAS unsigned char* lds, int h, int blk_begin, int blk_end) {
    int tid_ = threadIdx.x; asm volatile("" : "+v"(tid_));
    const int tid = tid_, lane = tid & 63, w = tid >> 6, fr = lane & 15, fq = lane >> 4;
    unsigned char* ws = p.ws;
    const bf16_t* P = (const bf16_t*)(ws + WS_P);
    const float* ss_cq = (const float*)(ws + WS_SS); const float* ss_ckv = ss_cq + MT;
    constexpr int WQS = 392, WKS = 264;
    LAS bf16_t* wl = (LAS bf16_t*)lds;
    LAS bf16_t* stg = (LAS bf16_t*)(lds + 83968 + w * 3328);
    float frq[4];
#pragma unroll
    for (int i = 0; i < 4; ++i) frq[i] = exp2f(-(float)(4 * fq + i) * (13.287712379549449f / 16.0f));
    __syncthreads();
    { const bf16_t* W = (const bf16_t*)(ws + WS_WUQ) + (size_t)(96 * h) * 384;
      for (int idx = tid; idx < 96 * 48; idx += 512) { const int r = idx / 48, c = idx % 48; *(LAS u32x4*)(wl + r * WQS + c * 8) = *(const u32x4*)(W + r * 384 + c * 8); } }
    __syncthreads();
    {
        bf16_t* Q = (bf16_t*)(ws + WS_Q);
        f32x4 gvv[6];
#pragma unroll
        for (int n = 0; n < 6; ++n) gvv[n] = *(const f32x4*)(p.in[8] + 16 * n + 4 * fq);
#pragma unroll 1
        for (int pb = blk_begin + 2 * w; pb < blk_end; pb += 16) {
            const bool two = (pb + 1) < blk_end;
            const int blk1 = two ? pb + 1 : pb;
            const int rowm[2] = {16 * pb + fr, 16 * blk1 + fr};
            bf16x8 af[2][12]; float ssv[2];
#pragma unroll
            for (int m = 0; m < 2; ++m) { ssv[m] = ss_cq[rowm[m]];
#pragma unroll
                for (int ks = 0; ks < 12; ++ks) af[m][ks] = *(const bf16x8*)(P + (size_t)rowm[m] * INP + 32 * ks + 8 * fq); }
            f32x4 acc[2][6];
#pragma unroll
            for (int m = 0; m < 2; ++m)
#pragma unroll
                for (int n = 0; n < 6; ++n) acc[m][n] = (f32x4){0.f, 0.f, 0.f, 0.f};
#pragma unroll
            for (int ks = 0; ks < 12; ++ks)
#pragma unroll
                for (int n = 0; n < 6; ++n) { const bf16x8 bw = *(const LAS bf16x8*)(wl + (16 * n + fr) * WQS + 32 * ks + 8 * fq);
                    acc[0][n] = MFMA16(bw, af[0][ks], acc[0][n]); acc[1][n] = MFMA16(bw, af[1][ks], acc[1][n]); }
#pragma unroll
            for (int mi = 0; mi < 2; ++mi) {
                const bool valid = (mi == 0) || two;
                const int t = rowm[mi] % TT;
                const float sc = frsq(ssv[mi] * (1.0f / 384.0f) + EPS);
                float ssq = 0.f;
#pragma unroll
                for (int n = 0; n < 6; ++n) { acc[mi][n] *= sc; ssq += (acc[mi][n][0] * acc[mi][n][0] + acc[mi][n][1] * acc[mi][n][1]) + (acc[mi][n][2] * acc[mi][n][2] + acc[mi][n][3] * acc[mi][n][3]); }
                ssq += __shfl_xor(ssq, 16); ssq += __shfl_xor(ssq, 32);
                const float rq = frsq(ssq * (1.0f / 96.0f) + EPS);
#pragma unroll
                for (int n = 0; n < 6; ++n) acc[mi][n] = acc[mi][n] * rq * gvv[n];
#pragma unroll
                for (int i = 0; i < 4; ++i) { float sn, cs; sincos_rr((float)t * frq[i], sn, cs);
                    const float x1 = acc[mi][4][i], x2 = acc[mi][5][i]; acc[mi][4][i] = x1 * cs - x2 * sn; acc[mi][5][i] = x1 * sn + x2 * cs; }
#pragma unroll
                for (int n = 0; n < 6; ++n) { u32x2 wv; wv.x = cvt_pk(acc[mi][n][0] * QSCALE, acc[mi][n][1] * QSCALE); wv.y = cvt_pk(acc[mi][n][2] * QSCALE, acc[mi][n][3] * QSCALE); *(LAS u32x2*)(stg + fr * 104 + 16 * n + 4 * fq) = wv; }
                asm volatile("s_waitcnt lgkmcnt(0)" ::: "memory");
#pragma unroll
                for (int j = 0; j < 3; ++j) { const int c = lane + 64 * j, rw = c / 12, cc = c % 12; const int row2 = 16 * (mi ? blk1 : pb) + rw, b2 = row2 / TT, t2 = row2 % TT;
                    const u32x4 v = *(const LAS u32x4*)(stg + rw * 104 + 8 * cc);
                    if (valid && t2 >= NMETA) __builtin_nontemporal_store(v, (u32x4*)(Q + (((size_t)(b2 * NH + h)) * SEQ + (t2 - NMETA)) * QKH + 8 * cc)); }
                asm volatile("s_waitcnt lgkmcnt(0)" ::: "memory"); __builtin_amdgcn_sched_barrier(0);
            }
        }
    }
    __syncthreads();
    { const bf16_t* W = (const bf16_t*)(ws + WS_WUKV) + (size_t)(128 * h) * 256;
      for (int idx = tid; idx < 128 * 32; idx += 512) { const int r = idx / 32, c = idx % 32; *(LAS u32x4*)(wl + r * WKS + c * 8) = *(const u32x4*)(W + r * 256 + c * 8); } }
    __syncthreads();
    {
        bf16_t* Kb = (bf16_t*)(ws + WS_K); bf16_t* Vt = (bf16_t*)(ws + WS_VT);
        f32x4 gvv[6];
#pragma unroll
        for (int n = 0; n < 6; ++n) gvv[n] = *(const f32x4*)(p.in[9] + 16 * n + 4 * fq);
#pragma unroll 1
        for (int pb = blk_begin + 2 * w; pb < blk_end; pb += 16) {
            const bool two = (pb + 1) < blk_end;
            const int blk1 = two ? pb + 1 : pb;
            const int rowm[2] = {16 * pb + fr, 16 * blk1 + fr};
            bf16x8 af[2][8]; float ssv[2]; u32x2 k1v[2], k2v[2];
#pragma unroll
            for (int m = 0; m < 2; ++m) { ssv[m] = ss_ckv[rowm[m]]; k1v[m] = *(const u32x2*)(P + (size_t)rowm[m] * INP + C_KR + 4 * fq); k2v[m] = *(const u32x2*)(P + (size_t)rowm[m] * INP + C_KR + 16 + 4 * fq);
#pragma unroll
                for (int ks = 0; ks < 8; ++ks) af[m][ks] = *(const bf16x8*)(P + (size_t)rowm[m] * INP + C_CKV + 32 * ks + 8 * fq); }
            {
                f32x4 acc[2][4];
#pragma unroll
                for (int m = 0; m < 2; ++m)
#pragma unroll
                    for (int n = 0; n < 4; ++n) acc[m][n] = (f32x4){0.f, 0.f, 0.f, 0.f};
#pragma unroll
                for (int ks = 0; ks < 8; ++ks)
#pragma unroll
                    for (int n = 0; n < 4; ++n) { const bf16x8 bw = *(const LAS bf16x8*)(wl + (16 * n + fr) * WKS + 32 * ks + 8 * fq);
                        acc[0][n] = MFMA16(bw, af[0][ks], acc[0][n]); acc[1][n] = MFMA16(bw, af[1][ks], acc[1][n]); }
#pragma unroll
                for (int mi = 0; mi < 2; ++mi) {
                    const bool valid = (mi == 0) || two;
                    const int t = rowm[mi] % TT;
                    const float sc = frsq(ssv[mi] * (1.0f / 256.0f) + EPS);
                    const u32x2 k1 = k1v[mi], k2 = k2v[mi];
                    f32x4 kr1 = (f32x4){bflo(k1.x), bfhi(k1.x), bflo(k1.y), bfhi(k1.y)}, kr2 = (f32x4){bflo(k2.x), bfhi(k2.x), bflo(k2.y), bfhi(k2.y)};
                    float ssq = (kr1[0] * kr1[0] + kr1[1] * kr1[1]) + (kr1[2] * kr1[2] + kr1[3] * kr1[3]) + (kr2[0] * kr2[0] + kr2[1] * kr2[1]) + (kr2[2] * kr2[2] + kr2[3] * kr2[3]);
#pragma unroll
                    for (int n = 0; n < 4; ++n) { acc[mi][n] *= sc; ssq += (acc[mi][n][0] * acc[mi][n][0] + acc[mi][n][1] * acc[mi][n][1]) + (acc[mi][n][2] * acc[mi][n][2] + acc[mi][n][3] * acc[mi][n][3]); }
                    ssq += __shfl_xor(ssq, 16); ssq += __shfl_xor(ssq, 32);
                    const float rk = frsq(ssq * (1.0f / 96.0f) + EPS);
                    LAS bf16_t* dstk = stg + fr * 104 + 4 * fq;
#pragma unroll
                    for (int n = 0; n < 4; ++n) { const f32x4 v = acc[mi][n] * rk * gvv[n]; u32x2 wv; wv.x = cvt_pk(v[0], v[1]); wv.y = cvt_pk(v[2], v[3]); *(LAS u32x2*)(dstk + 16 * n) = wv; }
                    { kr1 = kr1 * rk * gvv[4]; kr2 = kr2 * rk * gvv[5];
                      f32x4 o1, o2;
#pragma unroll
                      for (int i = 0; i < 4; ++i) { float sn, cs; sincos_rr((float)t * frq[i], sn, cs);
                          o1[i] = kr1[i] * cs - kr2[i] * sn; o2[i] = kr1[i] * sn + kr2[i] * cs; }
                      u32x2 wv; wv.x = cvt_pk(o1[0], o1[1]); wv.y = cvt_pk(o1[2], o1[3]); *(LAS u32x2*)(dstk + 64) = wv; wv.x = cvt_pk(o2[0], o2[1]); wv.y = cvt_pk(o2[2], o2[3]); *(LAS u32x2*)(dstk + 80) = wv; }
                    asm volatile("s_waitcnt lgkmcnt(0)" ::: "memory");
#pragma unroll
                    for (int j = 0; j < 3; ++j) { const int c = lane + 64 * j, rw = c / 12, cc = c % 12; const int row2 = 16 * (mi ? blk1 : pb) + rw, b2 = row2 / TT, t2 = row2 % TT;
                        const u32x4 v = *(const LAS u32x4*)(stg + rw * 104 + 8 * cc);
                        if (valid) __builtin_nontemporal_store(v, (u32x4*)(Kb + (((size_t)(b2 * NH + h)) * TKP + t2) * QKH + 8 * cc)); }
                    asm volatile("s_waitcnt lgkmcnt(0)" ::: "memory"); __builtin_amdgcn_sched_barrier(0);
                }
            }
            {
                f32x4 acc[2][4];
#pragma unroll
                for (int m = 0; m < 2; ++m)
#pragma unroll
                    for (int n = 0; n < 4; ++n) acc[m][n] = (f32x4){0.f, 0.f, 0.f, 0.f};
#pragma unroll
                for (int ks = 0; ks < 8; ++ks)
#pragma unroll
                    for (int n = 0; n < 4; ++n) { const bf16x8 bw = *(const LAS bf16x8*)(wl + (64 + 16 * n + fr) * WKS + 32 * ks + 8 * fq);
                        acc[0][n] = MFMA16(bw, af[0][ks], acc[0][n]); acc[1][n] = MFMA16(bw, af[1][ks], acc[1][n]); }
#pragma unroll
                for (int mi = 0; mi < 2; ++mi) {
                    const bool valid = (mi == 0) || two;
                    const float sc = frsq(ssv[mi] * (1.0f / 256.0f) + EPS);
#pragma unroll
                    for (int n = 0; n < 4; ++n)
#pragma unroll
                        for (int i = 0; i < 4; ++i) { const int d = 16 * n + 4 * fq + i; stg[d * 16 + fr] = (bf16_t)(cvt_pk(acc[mi][n][i] * sc, 0.f) & 0xffffu); }
                    asm volatile("s_waitcnt lgkmcnt(0)" ::: "memory");
                    { const int row2 = 16 * (mi ? blk1 : pb), b2 = row2 / TT, t2 = row2 % TT;
                      bf16_t* dstv = Vt + (((size_t)(b2 * NH + h)) * NKT + (t2 >> 6)) * 4096 + (t2 & 63);
#pragma unroll
                      for (int j = 0; j < 2; ++j) { const int c = lane + 64 * j, d = c >> 1, hf = c & 1; if (valid) __builtin_nontemporal_store(*(const LAS u32x4*)(stg + d * 16 + 8 * hf), (u32x4*)(dstv + d * 64 + 8 * hf)); } }
                    asm volatile("s_waitcnt lgkmcnt(0)" ::: "memory"); __builtin_amdgcn_sched_barrier(0);
                }
            }
        }
    }
}

#define LDS_BARRIER() asm volatile("s_waitcnt lgkmcnt(0)\n\ts_barrier" ::: "memory")
__device__ __forceinline__ float fsig(float x) { return __builtin_amdgcn_rcpf(1.0f + __builtin_amdgcn_exp2f(-1.4426950408889634f * x)); }
template <int DIR>
__device__ __forceinline__ void rnn_scan_unit(const Params& p, LAS unsigned char* lds, int b, int g) {
    int tid_ = threadIdx.x; asm volatile("" : "+v"(tid_));
    const int tid = tid_, lane = tid & 63, wid = tid >> 6, fr = lane & 15, fq = lane >> 4;
    unsigned char* ws = p.ws;
    const bf16_t* P = (const bf16_t*)(ws + WS_P);
    bf16_t* H = (bf16_t*)(ws + WS_H) + (size_t)DIR * MT * 512;
    constexpr int XS = 68;
    LAS unsigned char* wb = lds + wid * 14976;
    LAS bf16_t* xrb = (LAS bf16_t*)wb;
    LAS float* xcf = (LAS float*)(wb + 2432);
    LAS float* al = (LAS float*)(wb + 2432 + 4352);
    LAS float* bl = (LAS float*)(wb + 2432 + 4352 + 4096);
    LAS float* sg = (LAS float*)(lds + 8 * 14976);
    LAS bf16x8* wl = (LAS bf16x8*)(lds + 8 * 14976 + 8192);
    LAS float* cst = (LAS float*)(lds + 8 * 14976 + 8192 + 16384);
    __syncthreads();
    { const bf16_t* Wl = (const bf16_t*)(ws + WS_WLRU);
#pragma unroll
      for (int i = 0; i < 2; ++i) { const int f = wid * 2 + i, which = f >> 3, n = (f >> 1) & 3, ks = f & 1;
          wl[f * 64 + lane] = *(const bf16x8*)(Wl + ((size_t)((DIR * 2 + which) * 8 + g) * 64 + 16 * n + fr) * 64 + 32 * ks + 8 * fq); }
      if (tid < 64) { const int c = DIR * 512 + 64 * g + tid; cst[tid] = -1.4426950408889634f * p.in[13][c]; cst[64 + tid] = -1.4426950408889634f * p.in[15][c]; cst[128 + tid] = -8.0f * 1.4426950408889634f * log1pf(__expf(-p.in[16][c])); } }
    const int ch = lane, seg = wid;
    LDS_BARRIER();
    bf16x8 wreg[8];
#pragma unroll
    for (int f = 0; f < 8; ++f) wreg[f] = wl[f * 64 + lane];
    f32x4 cwv[4][2], cbv[2];
    { const int c0 = 64 * g + 8 * (lane & 7);
#pragma unroll
      for (int j = 0; j < 4; ++j) { cwv[j][0] = *(const f32x4*)(p.in[10] + j * 512 + c0); cwv[j][1] = *(const f32x4*)(p.in[10] + j * 512 + c0 + 4); }
      cbv[0] = *(const f32x4*)(p.in[11] + c0); cbv[1] = *(const f32x4*)(p.in[11] + c0 + 4); }
    float hcar = 0.f;
    u32x4 xw[3];
#define XR_LOAD(ckv) do { const int tb_ = 128 * (ckv) + 16 * wid - 2; _Pragma("unroll") for (int i = 0; i < 3; ++i) { const int idx = lane + 64 * i, r = idx >> 3, c8 = idx & 7, t = tb_ + r; \
        xw[i] = (u32x4){0u, 0u, 0u, 0u}; if (idx < 152 && t >= 0 && t < TT) xw[i] = *(const u32x4*)(P + ((size_t)b * TT + t) * INP + C_XR + 64 * g + 8 * c8); } } while (0)
    XR_LOAD(DIR == 0 ? 0 : NCH - 1);
#pragma unroll 1
    for (int ci = 0; ci < NCH; ++ci) {
        const int ck = DIR == 0 ? ci : NCH - 1 - ci, t0 = 128 * ck + 16 * wid;
#pragma unroll
        for (int i = 0; i < 3; ++i) { const int idx = lane + 64 * i; if (idx < 152) *(LAS u32x4*)(xrb + idx * 8) = xw[i]; }
        asm volatile("s_waitcnt lgkmcnt(0)" ::: "memory");
        if (ci + 1 < NCH) XR_LOAD(DIR == 0 ? ci + 1 : NCH - 2 - ci);
        { const int tl0 = lane >> 3, c8 = lane & 7;
#pragma unroll
          for (int hh = 0; hh < 2; ++hh) { const int tl = tl0 + 8 * hh;
              f32x4 o0 = cbv[0], o1 = cbv[1];
#pragma unroll
              for (int j = 0; j < 4; ++j) { const u32x4 xw_ = *(const LAS u32x4*)(xrb + (tl + j) * 64 + 8 * c8);
                  o0[0] += cwv[j][0][0] * bflo(xw_.x); o0[1] += cwv[j][0][1] * bfhi(xw_.x); o0[2] += cwv[j][0][2] * bflo(xw_.y); o0[3] += cwv[j][0][3] * bfhi(xw_.y);
                  o1[0] += cwv[j][1][0] * bflo(xw_.z); o1[1] += cwv[j][1][1] * bfhi(xw_.z); o1[2] += cwv[j][1][2] * bflo(xw_.w); o1[3] += cwv[j][1][3] * bfhi(xw_.w); }
              *(LAS f32x4*)(xcf + tl * XS + 8 * c8) = o0; *(LAS f32x4*)(xcf + tl * XS + 8 * c8 + 4) = o1; } }
        asm volatile("s_waitcnt lgkmcnt(0)" ::: "memory");
        { const int tt = fr; const bool valid = (t0 + tt) < TT;
          bf16x8 af[2];
#pragma unroll
          for (int ks = 0; ks < 2; ++ks) { const f32x4 x0 = *(const LAS f32x4*)(xcf + tt * XS + 32 * ks + 8 * fq), x1 = *(const LAS f32x4*)(xcf + tt * XS + 32 * ks + 8 * fq + 4);
              u32x4 w; w.x = cvt_pk(x0[0], x0[1]); w.y = cvt_pk(x0[2], x0[3]); w.z = cvt_pk(x1[0], x1[1]); w.w = cvt_pk(x1[2], x1[3]); af[ks] = __builtin_bit_cast(bf16x8, w); }
#pragma unroll
          for (int n = 0; n < 4; ++n) { const int c4 = 16 * n + 4 * fq;
              f32x4 ra = *(const LAS f32x4*)(cst + c4), ia = *(const LAS f32x4*)(cst + 64 + c4);
#pragma unroll
              for (int ks = 0; ks < 2; ++ks) { ra = MFMA16(wreg[(0 * 4 + n) * 2 + ks], af[ks], ra); ia = MFMA16(wl[((1 * 4 + n) * 2 + ks) * 64 + lane], af[ks], ia); }
              const f32x4 xv = *(const LAS f32x4*)(xcf + tt * XS + c4);
              const f32x4 spv = *(const LAS f32x4*)(cst + 128 + c4);
              f32x4 av, bv;
#pragma unroll
              for (int i = 0; i < 4; ++i) { const float r = __builtin_amdgcn_rcpf(1.0f + __builtin_amdgcn_exp2f(ra[i])), ig = __builtin_amdgcn_rcpf(1.0f + __builtin_amdgcn_exp2f(ia[i]));
                  const float a = __builtin_amdgcn_exp2f(r * spv[i]); const float em = fmaf(-a, a, 1.0f);
                  av[i] = valid ? a : 1.0f; bv[i] = valid ? __builtin_amdgcn_sqrtf(fmaxf(em, 0.0f)) * ig * xv[i] : 0.0f; }
              *(LAS f32x4*)(al + tt * 64 + c4) = av; *(LAS f32x4*)(bl + tt * 64 + c4) = bv; } }
        asm volatile("s_waitcnt lgkmcnt(0)" ::: "memory");
        LAS float* sgA = sg + (ci & 1) * 1024; LAS float* sgB = sgA + 512;
        float av_[16], bv_[16];
        { float A = 1.f, B = 0.f;
#pragma unroll
          for (int k = 0; k < 16; ++k) { const int tt = DIR == 0 ? k : 15 - k; av_[k] = al[tt * 64 + ch]; bv_[k] = bl[tt * 64 + ch]; B = av_[k] * B + bv_[k]; A *= av_[k]; }
          sgA[seg * 64 + ch] = A; sgB[seg * 64 + ch] = B; }
        LDS_BARRIER();
        float h = hcar, hin = hcar;
#pragma unroll
        for (int s = 0; s < 8; ++s) { const int sx = DIR == 0 ? s : 7 - s; hin = (sx == seg) ? h : hin; h = sgA[sx * 64 + ch] * h + sgB[sx * 64 + ch]; }
        hcar = h;
#pragma unroll
        for (int k = 0; k < 16; ++k) { const int tt = DIR == 0 ? k : 15 - k; hin = av_[k] * hin + bv_[k]; bl[tt * 64 + ch] = hin; }
        asm volatile("s_waitcnt lgkmcnt(0)" ::: "memory");
        { const int tk = lane >> 2, cq4 = lane & 3;
          if (t0 + tk < TT) { const LAS float* src = bl + tk * 64 + 16 * cq4;
              const f32x4 x0 = *(const LAS f32x4*)(src), x1 = *(const LAS f32x4*)(src + 4), x2 = *(const LAS f32x4*)(src + 8), x3 = *(const LAS f32x4*)(src + 12);
              u32x4 w0, w1; w0.x = cvt_pk(x0[0], x0[1]); w0.y = cvt_pk(x0[2], x0[3]); w0.z = cvt_pk(x1[0], x1[1]); w0.w = cvt_pk(x1[2], x1[3]);
              w1.x = cvt_pk(x2[0], x2[1]); w1.y = cvt_pk(x2[2], x2[3]); w1.z = cvt_pk(x3[0], x3[1]); w1.w = cvt_pk(x3[2], x3[3]);
              bf16_t* hp = H + ((size_t)b * TT + t0 + tk) * 512 + 64 * g + 16 * cq4;
              *(u32x4*)hp = w0; *(u32x4*)(hp + 8) = w1; } }
        asm volatile("s_waitcnt lgkmcnt(0)" ::: "memory");
    }
#undef XR_LOAD
    __syncthreads();
}
__device__ __forceinline__ void rnn_combine(const Params& p) {
    const int tid = threadIdx.x, lane = tid & 63, wave = tid >> 6;
    unsigned char* ws = p.ws;
    const bf16_t* P = (const bf16_t*)(ws + WS_P); const bf16_t* H0 = (const bf16_t*)(ws + WS_H); const bf16_t* H1 = H0 + (size_t)MT * 512;
    bf16_t* MIX = (bf16_t*)(ws + WS_MIX); float* ss_b = (float*)(ws + WS_SS) + 2 * MT + MR;
    const int NW = gridDim.x * 8;
    for (int r0 = blockIdx.x * 8 + wave; r0 < MR; r0 += 4 * NW) {
        u32x4 hf[4], hb[4], gw[4];
#pragma unroll
        for (int k = 0; k < 4; ++k) { const int rr = (r0 + k * NW < MR) ? r0 + k * NW : r0; const int b = rr / SEQ, sidx = rr % SEQ; const size_t src = (size_t)b * TT + sidx + NMETA;
            hf[k] = *(const u32x4*)(H0 + src * 512 + 8 * lane); hb[k] = *(const u32x4*)(H1 + src * 512 + 8 * lane); gw[k] = *(const u32x4*)(P + src * INP + C_GATE + 8 * lane); }
#pragma unroll
        for (int k = 0; k < 4; ++k) { const int rr = r0 + k * NW;
            float y[8]; float q = 0.f;
#pragma unroll
            for (int i = 0; i < 4; ++i) { const unsigned a = hf[k][i], c = hb[k][i], gg = gw[k][i];
#pragma unroll
                for (int e = 0; e < 2; ++e) { const float hs = (e ? bfhi(a) : bflo(a)) + (e ? bfhi(c) : bflo(c)); const float gt = e ? bfhi(gg) : bflo(gg);
                    const float u = 0.7978845608028654f * (gt + 0.044715f * gt * gt * gt); const float th = 1.0f - 2.0f * __builtin_amdgcn_rcpf(1.0f + __builtin_amdgcn_exp2f(2.8853900817779268f * u));
                    const float yv = hs * (0.5f * gt * (1.0f + th)); y[2 * i + e] = yv; q += yv * yv; } }
            q = wave_sum(q);
            if (rr < MR) { u32x4 w; w.x = cvt_pk(y[0], y[1]); w.y = cvt_pk(y[2], y[3]); w.z = cvt_pk(y[4], y[5]); w.w = cvt_pk(y[6], y[7]);
                *(u32x4*)(MIX + (size_t)rr * DM + 512 + 8 * lane) = w;
                if (lane == 0) ss_b[rr] = q; } }
    }
}

__device__ __forceinline__ void attn_unit(const Params& p, LAS unsigned char* lds, int bh, int qb) {
    int tid_ = threadIdx.x; asm volatile("" : "+v"(tid_));
    const int tid = tid_, lane = tid & 63, wid = tid >> 6, l31 = lane & 31, hi = lane >> 5;
    unsigned char* ws = p.ws;
    const bf16_t* Qg = (const bf16_t*)(ws + WS_Q) + ((size_t)bh * SEQ + qb * 256 + wid * 32 + l31) * QKH;
    const bf16_t* Kg = (const bf16_t*)(ws + WS_K) + (size_t)bh * TKP * QKH;
    const bf16_t* Vg = (const bf16_t*)(ws + WS_VT) + (size_t)bh * 64 * TKP;
    constexpr int KST = 208, VST = 144, KBUF = 64 * KST;
    bf16x8 qr[6];
#pragma unroll
    for (int ks = 0; ks < 6; ++ks) qr[ks] = *(const bf16x8*)(Qg + 16 * ks + 8 * hi);
    bool fast;
    { float gq = fabsf(p.in[8][lane]), gk = fabsf(p.in[9][lane]);
      if (lane < 32) { gq = fmaxf(gq, fabsf(p.in[8][64 + lane])); gk = fmaxf(gk, fabsf(p.in[9][64 + lane])); }
#pragma unroll
      for (int o = 1; o < 64; o <<= 1) { gq = fmaxf(gq, __shfl_xor(gq, o)); gk = fmaxf(gk, __shfl_xor(gk, o)); }
      fast = __builtin_amdgcn_readfirstlane((14.2f * gq * gk < 40.0f) ? 1 : 0) != 0; }
    const int kr0 = tid / 12, kc0 = tid % 12, i1 = tid + 512, kr1 = i1 / 12, kc1 = i1 % 12, vd = tid >> 3, vc = tid & 7;
    const bool two = tid < 256;
    const int pi = (l31 & 0x13) | ((l31 & 4) << 1) | ((l31 & 8) >> 1);
    constexpr int VOFF = 2 * KBUF, VBUF = 64 * VST;
#define QK_TILE(P0, P1, kb_) do { const float nm_ = -m_run; _Pragma("unroll") for (int r = 0; r < 16; ++r) { P0[r] = nm_; P1[r] = nm_; } \
        _Pragma("unroll") for (int ks = 0; ks < 6; ++ks) { \
            const bf16x8 a0_ = *(const LAS bf16x8*)((kb_) + pi * KST + (16 * ks + 8 * hi) * 2); \
            const bf16x8 a1_ = *(const LAS bf16x8*)((kb_) + (32 + pi) * KST + (16 * ks + 8 * hi) * 2); \
            P0 = MFMA32(a0_, qr[ks], P0); P1 = MFMA32(a1_, qr[ks], P1); } } while (0)
    float m_run = 0.f, l_run = 0.f;
    f32x16 o0, o1;
#pragma unroll
    for (int r = 0; r < 16; ++r) { o0[r] = 0.f; o1[r] = 0.f; }
    u32x4 sKa0 = (u32x4){0u, 0u, 0u, 0u}, sKb0 = sKa0, sVa0 = sKa0, sKa1 = sKa0, sKb1 = sKa0, sVa1 = sKa0;
    __syncthreads();
    { const u32x4 kA = *(const u32x4*)(Kg + kr0 * QKH + kc0 * 8); u32x4 kB = (u32x4){0u, 0u, 0u, 0u}; if (two) kB = *(const u32x4*)(Kg + kr1 * QKH + kc1 * 8);
      const u32x4 vA = *(const u32x4*)(Vg + vd * 64 + vc * 8);
      const bf16_t* k1 = Kg + (size_t)64 * QKH;
      sKa1 = *(const u32x4*)(k1 + kr0 * QKH + kc0 * 8); if (two) sKb1 = *(const u32x4*)(k1 + kr1 * QKH + kc1 * 8); sVa1 = *(const u32x4*)(Vg + (size_t)4096 + vd * 64 + vc * 8);
      *(LAS u32x4*)(lds + kr0 * KST + kc0 * 16) = kA; if (two) *(LAS u32x4*)(lds + kr1 * KST + kc1 * 16) = kB;
      *(LAS u32x4*)(lds + VOFF + vd * VST + vc * 16) = vA; }
    __syncthreads();
#define ATT_STEP(T_, FAST_, IKA, IKB, IVA, WKA, WKB, WVA) do { \
        const bool wr_ = ((T_) + 1) < NKT, iss_ = ((T_) + 2) < NKT; \
        if (iss_) { const bf16_t* kt = Kg + (size_t)((T_) + 2) * 64 * QKH; IKA = *(const u32x4*)(kt + kr0 * QKH + kc0 * 8); if (two) IKB = *(const u32x4*)(kt + kr1 * QKH + kc1 * 8); \
            IVA = *(const u32x4*)(Vg + (size_t)((T_) + 2) * 4096 + vd * 64 + vc * 8); } \
        LAS const unsigned char* kb_ = lds + ((T_) & 1) * KBUF; LAS const unsigned char* vb_ = lds + VOFF + ((T_) & 1) * VBUF; \
        f32x16 p0, p1; \
        QK_TILE(p0, p1, kb_); \
        if ((T_) == NKT - 1) { \
_Pragma("unroll") \
            for (int r = 8; r < 16; ++r) p0[r] = -INFINITY; \
_Pragma("unroll") \
            for (int r = 0; r < 16; ++r) p1[r] = -INFINITY; } \
        if (!(FAST_)) { \
            float mx = fmaxf(fmaxf(p0[0], p1[0]), fmaxf(p0[1], p1[1])); \
_Pragma("unroll") \
            for (int r = 2; r < 16; r += 2) mx = fmaxf(fmaxf(mx, fmaxf(p0[r], p1[r])), fmaxf(p0[r + 1], p1[r + 1])); \
            mx = fmaxf(mx, __shfl_xor(mx, 32)); \
            if (__any(mx > 8.0f)) { \
                const float dl = fmaxf(mx, 0.f); const float alpha = __builtin_amdgcn_exp2f(-dl); l_run *= alpha; m_run += dl; \
_Pragma("unroll") \
                for (int r = 0; r < 16; ++r) { o0[r] *= alpha; o1[r] *= alpha; p0[r] -= dl; p1[r] -= dl; } } } \
        float rs = 0.f; \
_Pragma("unroll") \
        for (int r = 0; r < 16; ++r) { p0[r] = __builtin_amdgcn_exp2f(p0[r]); p1[r] = __builtin_amdgcn_exp2f(p1[r]); rs += p0[r] + p1[r]; } \
        l_run += rs; \
        bf16x8 pb[2][2]; \
_Pragma("unroll") \
        for (int s = 0; s < 2; ++s) { u32x4 w0, w1; \
            w0.x = cvt_pk(p0[8 * s + 0], p0[8 * s + 1]); w0.y = cvt_pk(p0[8 * s + 2], p0[8 * s + 3]); w0.z = cvt_pk(p0[8 * s + 4], p0[8 * s + 5]); w0.w = cvt_pk(p0[8 * s + 6], p0[8 * s + 7]); \
            w1.x = cvt_pk(p1[8 * s + 0], p1[8 * s + 1]); w1.y = cvt_pk(p1[8 * s + 2], p1[8 * s + 3]); w1.z = cvt_pk(p1[8 * s + 4], p1[8 * s + 5]); w1.w = cvt_pk(p1[8 * s + 6], p1[8 * s + 7]); \
            pb[0][s] = __builtin_bit_cast(bf16x8, w0); pb[1][s] = __builtin_bit_cast(bf16x8, w1); } \
_Pragma("unroll") \
        for (int kb = 0; kb < 2; ++kb) \
_Pragma("unroll") \
            for (int s = 0; s < 2; ++s) { \
                const bf16x8 v0 = *(const LAS bf16x8*)(vb_ + l31 * VST + (32 * kb + 16 * s + 8 * hi) * 2); \
                const bf16x8 v1 = *(const LAS bf16x8*)(vb_ + (32 + l31) * VST + (32 * kb + 16 * s + 8 * hi) * 2); \
                o0 = MFMA32(v0, pb[kb][s], o0); o1 = MFMA32(v1, pb[kb][s], o1); } \
        if (wr_) { LAS unsigned char* nk_ = lds + (((T_) + 1) & 1) * KBUF; *(LAS u32x4*)(nk_ + kr0 * KST + kc0 * 16) = WKA; if (two) *(LAS u32x4*)(nk_ + kr1 * KST + kc1 * 16) = WKB; \
            LAS unsigned char* nv_ = lds + VOFF + (((T_) + 1) & 1) * VBUF; *(LAS u32x4*)(nv_ + vd * VST + vc * 16) = WVA; } \
        asm volatile("s_waitcnt lgkmcnt(0)\n\ts_barrier" ::: "memory"); \
    } while (0)
    if (fast) { int t = 0;
#pragma unroll 1
      for (; t + 1 < NKT; t += 2) { ATT_STEP(t, true, sKa0, sKb0, sVa0, sKa1, sKb1, sVa1); ATT_STEP(t + 1, true, sKa1, sKb1, sVa1, sKa0, sKb0, sVa0); }
      if (t < NKT) ATT_STEP(t, true, sKa0, sKb0, sVa0, sKa1, sKb1, sVa1); }
    else { int t = 0;
#pragma unroll 1
      for (; t + 1 < NKT; t += 2) { ATT_STEP(t, false, sKa0, sKb0, sVa0, sKa1, sKb1, sVa1); ATT_STEP(t + 1, false, sKa1, sKb1, sVa1, sKa0, sKb0, sVa0); }
      if (t < NKT) ATT_STEP(t, false, sKa0, sKb0, sVa0, sKa1, sKb1, sVa1); }
#undef ATT_STEP
#undef QK_TILE
    const float l = l_run + __shfl_xor(l_run, 32); const float inv = 1.0f / l;
    const int b = bh >> 3, h = bh & 7;
    const size_t rr = (size_t)b * SEQ + qb * 256 + wid * 32 + l31;
    LAS bf16_t* ost = (LAS bf16_t*)(lds + 45056 + wid * 4608);
    float q = 0.f;
#pragma unroll
    for (int gq = 0; gq < 4; ++gq) {
        const float a0 = o0[4 * gq] * inv, a1 = o0[4 * gq + 1] * inv, a2 = o0[4 * gq + 2] * inv, a3 = o0[4 * gq + 3] * inv;
        const float c0 = o1[4 * gq] * inv, c1 = o1[4 * gq + 1] * inv, c2 = o1[4 * gq + 2] * inv, c3 = o1[4 * gq + 3] * inv;
        q += (a0 * a0 + a1 * a1) + (a2 * a2 + a3 * a3) + (c0 * c0 + c1 * c1) + (c2 * c2 + c3 * c3);
        u32x2 w; w.x = cvt_pk(a0, a1); w.y = cvt_pk(a2, a3); *(LAS u32x2*)(ost + l31 * 72 + 8 * gq + 4 * hi) = w;
        w.x = cvt_pk(c0, c1); w.y = cvt_pk(c2, c3); *(LAS u32x2*)(ost + l31 * 72 + 32 + 8 * gq + 4 * hi) = w; }
    asm volatile("s_waitcnt lgkmcnt(0)" ::: "memory");
    { bf16_t* dstw = (bf16_t*)(ws + WS_MIX) + ((size_t)b * SEQ + qb * 256 + wid * 32) * DM + 64 * h;
#pragma unroll
      for (int j = 0; j < 4; ++j) { const int c = lane + 64 * j, row = c >> 3, c16 = c & 7; *(u32x4*)(dstw + (size_t)row * DM + 8 * c16) = *(const LAS u32x4*)(ost + row * 72 + 8 * c16); } }
    asm volatile("s_waitcnt lgkmcnt(0)" ::: "memory");
    q += __shfl_xor(q, 32);
    if (hi == 0) fadd_atomic((float*)(ws + WS_SS) + 2 * MT + rr, q);
}

#define XB_TMO      128
#define XB_XCNT(j)  (256  + 64 * (j))
#define XB_XSUB(j)  (1280 + 64 * (j))
#define XB_XGEN(j)  (2304 + 64 * (j))
#define XB_TOP      3328
#define XB_TOPGEN   3392
#define XCD_BAR_WORDS 3456
#define XB_SPIN_CAP (1u << 18)
__device__ __forceinline__ unsigned xb_ld(unsigned* p)              { return __hip_atomic_load(p, __ATOMIC_RELAXED, __HIP_MEMORY_SCOPE_AGENT); }
__device__ __forceinline__ unsigned xb_add(unsigned* p, unsigned v) { return __hip_atomic_fetch_add(p, v, __ATOMIC_RELAXED, __HIP_MEMORY_SCOPE_AGENT); }
__device__ __forceinline__ unsigned xb_xcc_id() { return (unsigned)__builtin_amdgcn_s_getreg((3 << 11) | 20) & 0xFu; }
#define XB_SPIN(cond, bar) do { unsigned _sp = 0; while (cond) { __builtin_amdgcn_s_sleep(1); \
    if ((++_sp & 255u) == 0u) { if (xb_ld(&(bar)[XB_TMO])) break; if (_sp > XB_SPIN_CAP) { atomicAdd(&(bar)[XB_TMO], 1u); break; } } } } while (0)
struct XcdBarrier { unsigned* bar; unsigned x; volatile LAS unsigned* st; };
__device__ __forceinline__ XcdBarrier xcd_barrier_post(unsigned* bar, volatile LAS unsigned* st) {
    XcdBarrier b; b.bar = bar; b.x = xb_xcc_id(); b.st = st;
    if (threadIdx.x == 0) (void)xb_add(&bar[XB_XCNT(b.x)], 1u);
    return b;
}
__device__ __forceinline__ void xcd_barrier_complete(unsigned* bar, unsigned x, unsigned& nloc, unsigned& nx) {
    const unsigned G = gridDim.x * gridDim.y * gridDim.z;
    unsigned sum, cnt, mine, sp = 0u;
    for (;;) {
        sum = 0u; cnt = 0u; mine = 0u;
#pragma unroll
        for (unsigned j = 0; j < 16; ++j) { const unsigned c = xb_ld(&bar[XB_XCNT(j)]); sum += c; cnt += (c > 0u) ? 1u : 0u; mine = (j == x) ? c : mine; }
        if (sum == G) break;
        __builtin_amdgcn_s_sleep(1);
        if ((++sp & 255u) == 0u) { if (xb_ld(&bar[XB_TMO])) break; if (sp > XB_SPIN_CAP) { atomicAdd(&bar[XB_TMO], 1u); break; } }
    }
    nloc = mine > 0u ? mine : 1u; nx = cnt > 0u ? cnt : 1u;
}
__device__ __forceinline__ void xcd_barrier(const XcdBarrier& b) {
    asm volatile("s_waitcnt vmcnt(0)" ::: "memory");
    __syncthreads();
    if (threadIdx.x == 0) {
        unsigned* bar = b.bar;
        __builtin_amdgcn_s_waitcnt(0);
        unsigned nloc = b.st[0], nx = b.st[1];
        if (nloc == 0u) { xcd_barrier_complete(bar, b.x, nloc, nx); b.st[0] = nloc; b.st[1] = nx; }
        const unsigned old = xb_add(&bar[XB_XSUB(b.x)], 1u);
        const unsigned gen = old / nloc;
        if (old + 1u == (gen + 1u) * nloc) {
            __builtin_amdgcn_fence(__ATOMIC_RELEASE, "agent");
            asm volatile("s_waitcnt vmcnt(0)" ::: "memory");
            const unsigned og = xb_add(&bar[XB_TOP], 1u);
            const unsigned tg = og / nx;
            if (og + 1u == (tg + 1u) * nx) xb_add(&bar[XB_TOPGEN], 1u);
            else XB_SPIN(xb_ld(&bar[XB_TOPGEN]) == tg, bar);
            __builtin_amdgcn_fence(__ATOMIC_ACQUIRE, "agent");
            xb_add(&bar[XB_XGEN(b.x)], 1u);
            asm volatile("s_waitcnt vmcnt(0)" ::: "memory");
        } else {
            XB_SPIN(xb_ld(&bar[XB_XGEN(b.x)]) == gen, bar);
            __builtin_amdgcn_fence(__ATOMIC_ACQUIRE, "agent");
            asm volatile("s_waitcnt vmcnt(0)" ::: "memory");
        }
    }
    __syncthreads();
}

__global__ void __launch_bounds__(512, 2) hymba_fwd(Params p) {
    extern __shared__ __attribute__((aligned(16))) unsigned char lds_raw[];
    LAS unsigned char* lds = (LAS unsigned char*)lds_raw;
    cg::grid_group grid = cg::this_grid();
    const int G = gridDim.x, bx = blockIdx.x;
    const int vcu = (G % 8 == 0) ? (bx % 8) * (G / 8) + bx / 8 : bx;
    unsigned char* ws = p.ws;
    float* ssf = (float*)(ws + WS_SS);
    const int lo = p.ph_lo, hi = p.ph_hi;
    volatile LAS unsigned* bst = (volatile LAS unsigned*)(lds + LDS_BYTES - 16);
    if (threadIdx.x < 4) bst[threadIdx.x] = 0u;
    __syncthreads();
    XcdBarrier xbar = xcd_barrier_post((unsigned*)(ws + WS_BAR) + p.li * XCD_BAR_WORDS, bst);
    if (lo == 12345) grid.sync();
#ifndef TEST_SUB
#define TEST_SUB -1
#endif
#ifndef TEST_PHASE
#define TEST_PHASE -1
#endif
#define IN(k) ((TEST_PHASE < 0 || TEST_PHASE == (k)) && lo <= (k) && (k) < hi)
#define SEAM(k) do { if (IN(k) && IN((k) + 1)) xcd_barrier(xbar); } while (0)
    if (IN(0)) { phase_prep(p, lds); } SEAM(0);
    if (IN(1)) { pg8::Gemm g{(const bf16_t*)(ws + WS_HB), (const bf16_t*)(ws + WS_WIN), MT, INP, 1024, 1024, 1024}; pg8::StaticOrder S; S.init(MT, INP, G, bx);
        pg8::EpiInProj E{(bf16_t*)(ws + WS_P), ssf + 2 * MT + 3 * MR, ssf, ssf + MT};
        pg8::gemm_phase<pg8::EpiInProj, pg8::StaticOrder, true>(lds, g, S, E);
        {
          const int nwg = (MT / 256) * (INP / 256), rounds = (nwg + G - 1) / G, first_idle = nwg - (rounds - 1) * G;
          const int n_idle = G - first_idle;
          if (n_idle <= 0) prep_transposes(p, lds, I_WIN, NIT, bx * 8 + (int)(threadIdx.x >> 6), G * 8);
          else if (bx >= first_idle) prep_transposes(p, lds, I_WIN, NIT, (bx - first_idle) * 8 + (int)(threadIdx.x >> 6), n_idle * 8); } } SEAM(1);
    if (IN(2)) { constexpr int NS = BATCH * 8 * 2, NHU = 8 * 32, NBLK = MT / 16;
        const int nun = (NS + NHU - vcu + G - 1) / G;
        for (int k = 0; k < nun; ++k) {
            const int kk = (((vcu >> 3) & 1) && nun == 2) ? 1 - k : k; const int u = vcu + kk * G;
            if (u < NS) { const int bg = u >> 1; if (u & 1) rnn_scan_unit<1>(p, lds, bg >> 3, bg & 7); else rnn_scan_unit<0>(p, lds, bg >> 3, bg & 7); }
            else { const int j = u - NS, hh = j & 7, r = j >> 3; qkv_head_unit(p, lds, hh, (r * NBLK) / 32, ((r + 1) * NBLK) / 32); } } } SEAM(2);
    if (IN(3)) { constexpr int NA = BATCH * NH * 8;
        const bool comb_first = ((vcu >> 3) & 1) == 0;
        if (comb_first) rnn_combine(p);
        for (int u = vcu; u < NA; u += G) attn_unit(p, lds, u >> 3, u & 7);
        if (!comb_first) rnn_combine(p); } SEAM(3);
    if (IN(4)) { pg8::Gemm g{(const bf16_t*)(ws + WS_MIX), (const bf16_t*)(ws + WS_WOUT), MR, 1024, 1024, 1024, 1024}; pg8::StaticOrder S; S.init(MR, 1024, G, bx);
        pg8::EpiOut E{p.in[0], (bf16_t*)(ws + WS_H), (bf16_t*)(ws + WS_HB), ssf + 2 * MT, ssf + 2 * MT + MR, ssf + 2 * MT + 2 * MR};
        pg8::gemm_phase<pg8::EpiOut, pg8::StaticOrder, true>(lds, g, S, E); } SEAM(4);
    if (IN(5)) { pg8::Gemm g{(const bf16_t*)(ws + WS_HB), (const bf16_t*)(ws + WS_WGU), MR, 2 * DFF, 1024, 1024, 1024}; pg8::StaticOrder S; S.init(MR, 2 * DFF, G, bx);
        pg8::EpiUp E{(bf16_t*)(ws + WS_P), ssf + 2 * MT + 2 * MR};
        pg8::gemm_phase<pg8::EpiUp, pg8::StaticOrder, true>(lds, g, S, E); } SEAM(5);
    if (IN(6)) { pg8::Gemm g{(const bf16_t*)(ws + WS_P), (const bf16_t*)(ws + WS_WDN), MR, 1024, DFF, DFF, DFF}; pg8::StaticOrder S; S.init(MR, 1024, G, bx);
        pg8::EpiDown E{p.out, (const bf16_t*)(ws + WS_HB), (const bf16_t*)(ws + WS_H)};
        pg8::gemm_phase<pg8::EpiDown, pg8::StaticOrder, true>(lds, g, S, E); }
#undef IN
#undef SEAM
}

#ifndef REPEAT_HI
#define REPEAT_HI -1
#endif
#ifndef N_LAUNCH_MODE
#define N_LAUNCH_MODE 1
#endif
extern "C" void kernel_launch(void* const* d_in, const int* in_sizes, int n_in, void* d_out, int out_size, void* d_ws, size_t ws_size, hipStream_t stream) {
    static int grid = 0;
    if (grid == 0) {
        if (n_in != 24 || out_size != MR * DM || ws_size < WS_END) { fprintf(stderr, "kernel_launch: unexpected problem (n_in %d, out %d, ws %zu)\n", n_in, out_size, ws_size); grid = -1; return; }
        int dev = 0, cus = 0, per_cu = 0;
        hipGetDevice(&dev); hipDeviceGetAttribute(&cus, hipDeviceAttributeMultiprocessorCount, dev);
        if (hipFuncSetAttribute((const void*)hymba_fwd, hipFuncAttributeMaxDynamicSharedMemorySize, LDS_BYTES) != hipSuccess) { fprintf(stderr, "kernel_launch: hipFuncSetAttribute failed\n"); grid = -1; return; }
        if (hipOccupancyMaxActiveBlocksPerMultiprocessor(&per_cu, (const void*)hymba_fwd, 512, LDS_BYTES) != hipSuccess || per_cu < 1) { fprintf(stderr, "kernel_launch: occupancy query gave %d\n", per_cu); per_cu = 1; }
        (void)hipGetLastError();
        grid = cus * per_cu;
    }
    if (grid < 0) return;
    Params p{};
    for (int i = 0; i < 24; ++i) p.in[i] = (const float*)d_in[i];
    p.out = (float*)d_out; p.ws = (unsigned char*)d_ws;
#if N_LAUNCH_MODE == 1
    void* args[] = {&p};
    (void)hipMemsetAsync((unsigned char*)d_ws + WS_BAR, 0, BAR_ZERO_BYTES, stream);
#if REPEAT_HI >= 0
    p.ph_lo = 0; p.ph_hi = REPEAT_HI + 1; p.li = 1;
    (void)hipLaunchCooperativeKernel((const void*)hymba_fwd, dim3(grid), dim3(512), args, LDS_BYTES, stream);
#endif
    p.ph_lo = 0; p.ph_hi = 7; p.li = 0;
    hipError_t e = hipLaunchCooperativeKernel((const void*)hymba_fwd, dim3(grid), dim3(512), args, LDS_BYTES, stream);
    if (e != hipSuccess) fprintf(stderr, "cooperative launch failed: %s (grid %d)\n", hipGetErrorString(e), grid);
#else
    for (int ph = 0; ph < 7; ++ph) { p.ph_lo = ph; p.ph_hi = ph + 1; p.li = 0; hipLaunchKernelGGL(hymba_fwd, dim3(grid), dim3(512), LDS_BYTES, stream, p); }
#endif
}
```
